# Optimizing an MI355X kernel written in HIP

```python
import jax, jax.numpy as jnp
from jax import lax
import numpy as np

D_MODEL = 1024
BATCH = 8
SEQ = 2048
DEPTH = 4

N_MIXERS = 3
D_RNN = D_MODEL
LRU_BLOCKS = 8
LRU_BW = D_RNN // LRU_BLOCKS
CONV_WIDTH = 4
LRU_C = 8.0
POOL_WINDOWS = (2, 4, 8, 16)
POOL_GROUPS = len(POOL_WINDOWS)
POOL_GW = D_MODEL // POOL_GROUPS
FOX_HEADS = 16
FOX_HEAD_DIM = D_MODEL // FOX_HEADS
Q_BLOCK = 128
D_FF = 7 * D_MODEL // 2
N_EXPERTS = 8
TOP_K = 2
MOE_ROW_BLOCK = 256
LN_EPS = 1e-5
NEG_INF = -1e30
ALPHA = (2 * DEPTH) ** 0.25
BETA = (8 * DEPTH) ** -0.25
N_A = (DEPTH + 2) // 3
N_B = (DEPTH + 1) // 3
N_C = DEPTH // 3
N_DENSE = (DEPTH + 1) // 2
N_MOE = DEPTH // 2

kernel_name = "hybrid_rglru_pool_fox_moe_deepnorm"


def layer_norm(x, g, b):
    xf = x.astype(jnp.float32)
    mu = jnp.mean(xf, axis=-1, keepdims=True)
    var = jnp.mean(jnp.square(xf - mu), axis=-1, keepdims=True)
    y = (xf - mu) * lax.rsqrt(var + LN_EPS)
    return (y * g.astype(jnp.float32) + b.astype(jnp.float32)).astype(x.dtype)


def causal_dwconv(x, w, b):
    S = x.shape[1]
    xp = jnp.pad(x, ((0, 0), (CONV_WIDTH - 1, 0), (0, 0)))
    y = b
    for k in range(CONV_WIDTH):
        y = y + xp[:, k:k + S] * w[k]
    return y


def _lru_combine(c1, c2):
    a1, b1 = c1
    a2, b2 = c2
    return a1 * a2, a2 * b1 + b2


def rglru_block(x, w_in, conv_w, conv_b, w_gates, b_gates, lam, w_out):
    B, S, _ = x.shape
    u = x @ w_in
    gate_branch, rec_branch = jnp.split(u, 2, axis=-1)
    y_gate = jax.nn.gelu(gate_branch, approximate=True)
    xr = causal_dwconv(rec_branch, conv_w, conv_b)
    xb = xr.reshape(B, S, LRU_BLOCKS, LRU_BW)
    z = jnp.einsum('bsnc,ncg->bsng', xb, w_gates).astype(jnp.float32) + b_gates.astype(jnp.float32)
    r = jax.nn.sigmoid(z[..., :LRU_BW])
    i = jax.nn.sigmoid(z[..., LRU_BW:])
    lam_b = lam.astype(jnp.float32).reshape(LRU_BLOCKS, LRU_BW)
    log_a = -LRU_C * r * jax.nn.softplus(-lam_b)
    a = jnp.exp(log_a)
    mult = jnp.sqrt(-jnp.expm1(2.0 * log_a))
    bterm = mult * (i * xb.astype(jnp.float32))
    a = a.reshape(B, S, D_RNN)
    bterm = bterm.reshape(B, S, D_RNN)
    _, h = lax.associative_scan(_lru_combine, (a, bterm), axis=1)
    return (y_gate * h.astype(x.dtype)) @ w_out


def pool_mixer(x, w, scale):
    B, S, D = x.shape
    xf = x.astype(jnp.float32)
    cs = jnp.cumsum(xf, axis=1)
    t = jnp.arange(1, S + 1, dtype=jnp.float32)[:, None]
    outs = []
    for g, wl in enumerate(POOL_WINDOWS):
        csg = cs[..., g * POOL_GW:(g + 1) * POOL_GW]
        prev = jnp.pad(csg, ((0, 0), (wl, 0), (0, 0)))[:, :S]
        mean = (csg - prev) / jnp.minimum(t, float(wl))
        outs.append(mean - xf[..., g * POOL_GW:(g + 1) * POOL_GW])
    p = jnp.stack(outs, axis=2).astype(x.dtype)
    y = jnp.einsum('bsgc,gcd->bsgd', p, w).reshape(B, S, D)
    return y * scale


def fox_attention(x, w_qkvf, b_f, w_o):
    B, S, D = x.shape
    proj = x @ w_qkvf
    q = proj[..., :D].reshape(B, S, FOX_HEADS, FOX_HEAD_DIM).transpose(0, 2, 1, 3)
    k = proj[..., D:2 * D].reshape(B, S, FOX_HEADS, FOX_HEAD_DIM).transpose(0, 2, 1, 3)
    v = proj[..., 2 * D:3 * D].reshape(B, S, FOX_HEADS, FOX_HEAD_DIM).transpose(0, 2, 1, 3)
    log_f = jax.nn.log_sigmoid(proj[..., 3 * D:].astype(jnp.float32) + b_f.astype(jnp.float32))
    F = jnp.cumsum(log_f, axis=1).transpose(0, 2, 1)
    nq = S // Q_BLOCK
    qb = q.reshape(B, FOX_HEADS, nq, Q_BLOCK, FOX_HEAD_DIM).transpose(2, 0, 1, 3, 4)
    Fq = F.reshape(B, FOX_HEADS, nq, Q_BLOCK).transpose(2, 0, 1, 3)
    qpos = jnp.arange(S, dtype=jnp.int32).reshape(nq, Q_BLOCK)
    kpos = jnp.arange(S, dtype=jnp.int32)
    scale = FOX_HEAD_DIM ** -0.5

    def block(args):
        qi, fi, pi = args
        s = jnp.einsum('bhqd,bhkd->bhqk', qi, k, preferred_element_type=jnp.float32) * scale
        s = s + fi[..., None] - F[:, :, None, :]
        s = jnp.where(kpos[None, :] <= pi[:, None], s, NEG_INF)
        p = jax.nn.softmax(s, axis=-1).astype(v.dtype)
        return jnp.einsum('bhqk,bhkd->bhqd', p, v)

    o = lax.map(block, (qb, Fq, qpos))
    o = o.transpose(1, 0, 3, 2, 4).reshape(B, S, D)
    return o @ w_o


def swiglu(x, w_gu, w_down):
    g, u = jnp.split(x @ w_gu, 2, axis=-1)
    return (jax.nn.silu(g) * u) @ w_down


def moe_swiglu(x, w_router, w_gu, w_down):
    B, S, D = x.shape
    T = B * S
    TK = T * TOP_K
    xt = x.reshape(T, D)
    logits = jnp.einsum('td,de->te', xt, w_router, preferred_element_type=jnp.float32)
    top_val, top_idx = lax.top_k(logits, TOP_K)
    gates = jax.nn.softmax(top_val, axis=-1)
    e_flat = top_idx.reshape(-1).astype(jnp.int32)
    g_flat = gates.reshape(-1)
    tok_flat = jnp.arange(TK, dtype=jnp.int32) // TOP_K
    order = jnp.argsort(e_flat)
    e_sorted = e_flat[order]
    tok_sorted = tok_flat[order]
    g_sorted = g_flat[order]
    counts = jnp.bincount(e_flat, length=N_EXPERTS).astype(jnp.int32)
    padded = (counts + MOE_ROW_BLOCK - 1) // MOE_ROW_BLOCK * MOE_ROW_BLOCK
    start = jnp.cumsum(counts) - counts
    pend = jnp.cumsum(padded)
    pstart = pend - padded
    dest = pstart[e_sorted] + jnp.arange(TK, dtype=jnp.int32) - start[e_sorted]
    n_blocks = (TK + N_EXPERTS * (MOE_ROW_BLOCK - 1) + MOE_ROW_BLOCK - 1) // MOE_ROW_BLOCK
    rows = jnp.zeros((n_blocks * MOE_ROW_BLOCK, D), x.dtype).at[dest].set(xt[tok_sorted])
    block_start = jnp.arange(n_blocks, dtype=jnp.int32) * MOE_ROW_BLOCK
    block_expert = jnp.minimum(jnp.searchsorted(pend, block_start, side='right'), N_EXPERTS - 1)

    def expert_block(args):
        xb, e = args
        return swiglu(xb, w_gu[e], w_down[e])

    y_rows = lax.map(expert_block, (rows.reshape(n_blocks, MOE_ROW_BLOCK, D), block_expert))
    y_sorted = y_rows.reshape(-1, D)[dest] * g_sorted[:, None].astype(x.dtype)
    y = jax.ops.segment_sum(y_sorted, tok_sorted, num_segments=T)
    return y.reshape(B, S, D)


def setup_inputs(seed: int = 0) -> dict:
    key = jax.random.key(seed)
    ks = jax.random.split(key, 24)
    D = D_MODEL
    f32 = jnp.float32

    def nrm(k, shape, s):
        return jax.random.normal(k, shape, f32) * s

    x = nrm(ks[0], (BATCH, SEQ, D), 1.0)
    lru_w_in = nrm(ks[1], (N_A, D, 2 * D_RNN), D ** -0.5)
    lru_conv_w = nrm(ks[2], (N_A, CONV_WIDTH, D_RNN), CONV_WIDTH ** -0.5)
    lru_conv_b = nrm(ks[3], (N_A, D_RNN), 0.02)
    lru_w_gates = nrm(ks[4], (N_A, LRU_BLOCKS, LRU_BW, 2 * LRU_BW), LRU_BW ** -0.5)
    lru_b_gates = nrm(ks[5], (N_A, LRU_BLOCKS, 2 * LRU_BW), 0.1)
    a_c = jax.random.uniform(ks[6], (N_A, D_RNN), f32, 0.9, 0.999)
    a0 = a_c ** (1.0 / LRU_C)
    lru_lambda = jnp.log(a0) - jnp.log1p(-a0)
    lru_w_out = nrm(ks[7], (N_A, D_RNN, D), D_RNN ** -0.5 * BETA)
    pool_w = nrm(ks[8], (N_B, POOL_GROUPS, POOL_GW, POOL_GW), POOL_GW ** -0.5 * BETA)
    pool_scale = 1.0 + nrm(ks[9], (N_B, D), 0.1)
    w_qk = nrm(ks[10], (N_C, D, 2 * D), D ** -0.5)
    w_v = nrm(ks[11], (N_C, D, D), D ** -0.5 * BETA)
    w_f = nrm(ks[12], (N_C, D, FOX_HEADS), D ** -0.5)
    fox_w_qkvf = jnp.concatenate([w_qk, w_v, w_f], axis=-1)
    fox_b_f = jax.random.uniform(ks[13], (N_C, FOX_HEADS), f32, 1.0, 4.0)
    fox_w_o = nrm(ks[14], (N_C, D, D), D ** -0.5 * BETA)
    ffn_w_gu = nrm(ks[15], (N_DENSE, D, 2 * D_FF), D ** -0.5)
    ffn_w_down = nrm(ks[16], (N_DENSE, D_FF, D), D_FF ** -0.5 * BETA)
    moe_router = nrm(ks[17], (N_MOE, D, N_EXPERTS), D ** -0.5)
    moe_w_gu = nrm(ks[18], (N_MOE, N_EXPERTS, D, 2 * D_FF), D ** -0.5)
    moe_w_down = nrm(ks[19], (N_MOE, N_EXPERTS, D_FF, D), D_FF ** -0.5 * BETA)
    ln_mix_g = 1.0 + nrm(ks[20], (DEPTH, D), 0.05)
    ln_mix_b = nrm(ks[21], (DEPTH, D), 0.02)
    ln_ffn_g = 1.0 + nrm(ks[22], (DEPTH, D), 0.05)
    ln_ffn_b = nrm(ks[23], (DEPTH, D), 0.02)
    return {"x": x, "lru_w_in": lru_w_in, "lru_conv_w": lru_conv_w, "lru_conv_b": lru_conv_b,
            "lru_w_gates": lru_w_gates, "lru_b_gates": lru_b_gates, "lru_lambda": lru_lambda,
            "lru_w_out": lru_w_out, "pool_w": pool_w, "pool_scale": pool_scale,
            "fox_w_qkvf": fox_w_qkvf, "fox_b_f": fox_b_f, "fox_w_o": fox_w_o,
            "ffn_w_gu": ffn_w_gu, "ffn_w_down": ffn_w_down, "moe_router": moe_router,
            "moe_w_gu": moe_w_gu, "moe_w_down": moe_w_down, "ln_mix_g": ln_mix_g,
            "ln_mix_b": ln_mix_b, "ln_ffn_g": ln_ffn_g, "ln_ffn_b": ln_ffn_b}


def reference(x, lru_w_in, lru_conv_w, lru_conv_b, lru_w_gates, lru_b_gates, lru_lambda,
              lru_w_out, pool_w, pool_scale, fox_w_qkvf, fox_b_f, fox_w_o, ffn_w_gu, ffn_w_down,
              moe_router, moe_w_gu, moe_w_down, ln_mix_g, ln_mix_b, ln_ffn_g, ln_ffn_b):
    for i in range(DEPTH):
        m = i % N_MIXERS
        j = i // N_MIXERS
        if m == 0:
            h = rglru_block(x, lru_w_in[j], lru_conv_w[j], lru_conv_b[j], lru_w_gates[j],
                            lru_b_gates[j], lru_lambda[j], lru_w_out[j])
        elif m == 1:
            h = pool_mixer(x, pool_w[j], pool_scale[j])
        else:
            h = fox_attention(x, fox_w_qkvf[j], fox_b_f[j], fox_w_o[j])
        x = layer_norm(ALPHA * x + h, ln_mix_g[i], ln_mix_b[i])
        if i % 2 == 0:
            f = swiglu(x, ffn_w_gu[i // 2], ffn_w_down[i // 2])
        else:
            f = moe_swiglu(x, moe_router[i // 2], moe_w_gu[i // 2], moe_w_down[i // 2])
        x = layer_norm(ALPHA * x + f, ln_ffn_g[i], ln_ffn_b[i])
    return x
```

```cpp
#define MK_N_LAUNCHES 1
#include <hip/hip_runtime.h>
#include <hip/hip_bf16.h>
#include <cstdio>
#include <cstdint>
#include <cmath>
namespace pg8 {
#define PG8_LAS __attribute__((address_space(3)))
typedef unsigned short bf16_t;
typedef short bf16x8 __attribute__((ext_vector_type(8)));
typedef float f32x4 __attribute__((ext_vector_type(4)));
typedef unsigned u32x4 __attribute__((ext_vector_type(4)));
constexpr int BM = 256, BK = 64, HALF = 128, HTB = HALF * BK * 2  , STAGE_BYTES = 8 * HTB, NXCD = 8, WGM = 8;

__host__ __device__ __forceinline__ int lds_byte(int r, int c) { const int st = (r >> 4) * 2 + (c >> 5), rr = r & 15, cc = c & 31, ob = rr * 64 + cc * 2; return st * 1024 + (ob ^ (((ob >> 9) & 1) << 5)); }
__host__ __device__ __forceinline__ void stage_rc(int b, int& R, int& C) { const int st = b / 1024, sb = b % 1024, swz = sb ^ (((sb >> 9) & 1) << 5); R = (st >> 1) * 16 + swz / 64; C = (st & 1) * 32 + (swz % 64) / 2; }
__host__ __device__ __forceinline__ int perm32(int rho) { const int n = rho >> 4, i = rho & 15; return 8 * (i >> 2) + 4 * n + (i & 3); }

__device__ __forceinline__ int fresh_lane() { int l; asm volatile("v_mbcnt_lo_u32_b32 %0, -1, 0\n\tv_mbcnt_hi_u32_b32 %0, -1, %0" : "=v"(l)); return l; }
struct Unit { int pm, pn; size_t aoff, boff; };
struct Gemm { const bf16_t* A; const bf16_t* Bt; int lda, ldb, K; };

struct Order {
    int nM, nN, nwg, G, c; unsigned a_pm, a_pn, b_pn, b_e; const int* blk_e;
    __device__ __forceinline__ void init(int nM_, int nN_, int G_, int c_, unsigned a_pm_, unsigned a_pn_, unsigned b_pn_, const int* blk_e_, unsigned b_e_) {
        nM = nM_; nN = nN_; nwg = nM * nN; G = G_; c = c_; a_pm = a_pm_; a_pn = a_pn_; b_pn = b_pn_; blk_e = blk_e_; b_e = b_e_; }
    __device__ __forceinline__ bool next(int i, Unit& u) const {
        const long L = (long)i * G + c; if (L >= nwg) return false;
        int wgid = (int)L; { const int q = nwg / NXCD, r = nwg % NXCD, xcd = wgid % NXCD, off = wgid / NXCD; wgid = (xcd < r ? xcd * (q + 1) : r * (q + 1) + (xcd - r) * q) + off; }
        const int nig = WGM * nN, gid = wgid / nig, fm = gid * WGM, gsz = (nM - fm) < WGM ? (nM - fm) : WGM;
        u.pm = fm + ((wgid % nig) % gsz); u.pn = (wgid % nig) / gsz;
        u.aoff = (size_t)u.pm * a_pm + (size_t)u.pn * a_pn; u.boff = (size_t)u.pn * b_pn;
        if (blk_e) { const int e = __builtin_amdgcn_readfirstlane(__hip_atomic_load(blk_e + u.pm, __ATOMIC_RELAXED, __HIP_MEMORY_SCOPE_AGENT)); u.boff += (size_t)e * b_e; }
        return true;
    }
    __device__ __forceinline__ void a_ready(const Unit&) const {}
    __device__ __forceinline__ void done(const Unit&) const {}
};

__device__ __forceinline__ unsigned cvt_pk_bf16(float lo, float hi) { unsigned r; asm volatile("v_cvt_pk_bf16_f32 %0, %1, %2" : "=v"(r) : "v"(lo), "v"(hi)); return r; }
__device__ __forceinline__ float bf_lo(unsigned w) { return __uint_as_float(w << 16); }
__device__ __forceinline__ float bf_hi(unsigned w) { return __uint_as_float(w & 0xffff0000u); }
__device__ __forceinline__ float fast_sigmoid(float v) { return __builtin_amdgcn_rcpf(1.0f + __builtin_amdgcn_exp2f(-1.4426950408889634f * v)); }
__device__ __forceinline__ float gelu_tanh(float v) { const float t = v + 0.044715f * v * v * v; return v * __builtin_amdgcn_rcpf(1.0f + __builtin_amdgcn_exp2f(-2.302208198f * t)); }

__device__ __forceinline__ float one_minus_exp(float x) {
    float p = x * (1.0f / 5040.0f) + (1.0f / 720.0f); p = p * x + (1.0f / 120.0f); p = p * x + (1.0f / 24.0f); p = p * x + (1.0f / 6.0f); p = p * x + 0.5f; p = p * x + 1.0f;
    const float big = 1.0f - __builtin_amdgcn_exp2f(1.4426950408889634f * x);
    return x > -0.25f ? -(p * x) : big;
}
__device__ __forceinline__ float softplus_f(float y) {
    const float t = __builtin_amdgcn_exp2f(-1.4426950408889634f * __builtin_fabsf(y));
    float p = t * 0.2f - 0.25f; p = p * t + (1.0f / 3.0f); p = p * t - 0.5f; p = p * t + 1.0f;
    const float l1p = t < 0.0625f ? p * t : 0.6931471805599453f * __builtin_amdgcn_logf(1.0f + t);
    return __builtin_fmaxf(y, 0.f) + l1p;
}
struct EpiBf16 {
    static constexpr bool PERM = true, AFTER_DRAIN = false;
    bf16_t* O; int ldc; int split_cols; size_t split_stride; float scale0;
    __device__ __forceinline__ void operator()(const f32x4 (&acc)[2][2][4][2], const Unit& u, int wr, int wc, int fr, int fq) const {
        const int row0 = u.pm * BM + wr * 64 + fr; int colt = u.pn * BM; bf16_t* base = O;
        float sc = 1.f; { const int t = colt / split_cols; base += (size_t)t * split_stride; colt -= t * split_cols; if (t == 0) sc = scale0; }
        const int col0 = colt + wc * 32 + 8 * fq;
#pragma unroll
        for (int ai = 0; ai < 2; ++ai)
#pragma unroll
            for (int m = 0; m < 4; ++m) { bf16_t* rowp = base + (size_t)(row0 + ai * HALF + m * 16) * ldc + col0;
#pragma unroll
                for (int bj = 0; bj < 2; ++bj) { f32x4 v0 = acc[ai][bj][m][0] * sc, v1 = acc[ai][bj][m][1] * sc;
                    u32x4 w; w.x = cvt_pk_bf16(v0[0], v0[1]); w.y = cvt_pk_bf16(v0[2], v0[3]); w.z = cvt_pk_bf16(v1[0], v1[1]); w.w = cvt_pk_bf16(v1[2], v1[3]);
                    *(u32x4*)(rowp + bj * HALF) = w; } }
    }
};
struct EpiLruIn {
    static constexpr bool PERM = true, AFTER_DRAIN = false;
    bf16_t* YG; float* REC;
    __device__ __forceinline__ void operator()(const f32x4 (&acc)[2][2][4][2], const Unit& u, int wr, int wc, int fr, int fq) const {
        const int row0 = u.pm * BM + wr * 64 + fr;
        if (u.pn < 4) {
            const int col0 = u.pn * BM + wc * 32 + 8 * fq;
#pragma unroll
            for (int ai = 0; ai < 2; ++ai)
#pragma unroll
                for (int m = 0; m < 4; ++m) { bf16_t* rowp = YG + (size_t)(row0 + ai * HALF + m * 16) * 1024 + col0;
#pragma unroll
                    for (int bj = 0; bj < 2; ++bj) { const f32x4 v0 = acc[ai][bj][m][0], v1 = acc[ai][bj][m][1];
                        u32x4 w; w.x = cvt_pk_bf16(gelu_tanh(v0[0]), gelu_tanh(v0[1])); w.y = cvt_pk_bf16(gelu_tanh(v0[2]), gelu_tanh(v0[3]));
                        w.z = cvt_pk_bf16(gelu_tanh(v1[0]), gelu_tanh(v1[1])); w.w = cvt_pk_bf16(gelu_tanh(v1[2]), gelu_tanh(v1[3]));
                        *(u32x4*)(rowp + bj * HALF) = w; } }
        } else {
            const int col0 = (u.pn - 4) * BM + wc * 32 + 8 * fq;
#pragma unroll
            for (int ai = 0; ai < 2; ++ai)
#pragma unroll
                for (int m = 0; m < 4; ++m) { float* rowp = REC + (size_t)(row0 + ai * HALF + m * 16) * 1024 + col0;
#pragma unroll
                    for (int bj = 0; bj < 2; ++bj) { *(f32x4*)(rowp + bj * HALF) = acc[ai][bj][m][0]; *(f32x4*)(rowp + bj * HALF + 4) = acc[ai][bj][m][1]; } }
        }
    }
};
struct EpiGates {
    static constexpr bool PERM = true, AFTER_DRAIN = false;
    const bf16_t* XR; const float* bg; const float* lam; float* AA; float* BB;
    __device__ __forceinline__ void operator()(const f32x4 (&acc)[2][2][4][2], const Unit& u, int wr, int wc, int fr, int fq) const {
        const int row0 = u.pm * BM + wr * 64 + fr; const int cl = wc * 32 + 8 * fq, cg = u.pn * 128 + cl;
        float br[8], bi[8], sp[8];
#pragma unroll
        for (int q = 0; q < 8; ++q) { br[q] = bg[u.pn * 256 + cl + q]; bi[q] = bg[u.pn * 256 + 128 + cl + q]; sp[q] = 8.0f * softplus_f(-lam[cg + q]); }
#pragma unroll
        for (int ai = 0; ai < 2; ++ai)
#pragma unroll
            for (int m = 0; m < 4; ++m) { const size_t off = (size_t)(row0 + ai * HALF + m * 16) * 1024 + cg;
                const u32x4 xw = *(const u32x4*)(XR + off);
                float xr[8] = {bf_lo(xw.x), bf_hi(xw.x), bf_lo(xw.y), bf_hi(xw.y), bf_lo(xw.z), bf_hi(xw.z), bf_lo(xw.w), bf_hi(xw.w)};
                f32x4 av[2], bv[2];
#pragma unroll
                for (int n = 0; n < 2; ++n)
#pragma unroll
                    for (int j = 0; j < 4; ++j) { const int q = 4 * n + j;
                        const float r = fast_sigmoid(acc[ai][0][m][n][j] + br[q]), ig = fast_sigmoid(acc[ai][1][m][n][j] + bi[q]);
                        const float la = -sp[q] * r; const float a = __builtin_amdgcn_exp2f(1.4426950408889634f * la); const float mult = __builtin_amdgcn_sqrtf(one_minus_exp(2.0f * la));
                        av[n][j] = a; bv[n][j] = mult * (ig * xr[q]); }
                *(f32x4*)(AA + off) = av[0]; *(f32x4*)(AA + off + 4) = av[1]; *(f32x4*)(BB + off) = bv[0]; *(f32x4*)(BB + off + 4) = bv[1]; }
    }
};
template <bool RES> struct EpiPre {
    static constexpr bool PERM = false, AFTER_DRAIN = false;
    const float* res; float* out; int ldc; const float* scale; float alpha;
    __device__ __forceinline__ void operator()(const f32x4 (&acc)[2][2][4][2], const Unit& u, int wr, int wc, int fr, int fq) const {
        const int row0 = u.pm * BM + wr * 64 + fr, col0 = u.pn * BM + wc * 32 + 4 * fq;
        f32x4 sv[2][2];
#pragma unroll
        for (int bj = 0; bj < 2; ++bj)
#pragma unroll
            for (int n = 0; n < 2; ++n) sv[bj][n] = scale ? *(const f32x4*)(scale + col0 + bj * HALF + n * 16) : (f32x4){1.f, 1.f, 1.f, 1.f};
#pragma unroll
        for (int ai = 0; ai < 2; ++ai)
#pragma unroll
            for (int m = 0; m < 4; ++m) { const size_t off = (size_t)(row0 + ai * HALF + m * 16) * ldc + col0;
#pragma unroll
                for (int bj = 0; bj < 2; ++bj)
#pragma unroll
                    for (int n = 0; n < 2; ++n) { f32x4 o = acc[ai][bj][m][n] * sv[bj][n];
                        if (RES) { const f32x4 r = *(const f32x4*)(res + off + bj * HALF + n * 16); o = r * alpha + o; }
                        *(f32x4*)(out + off + bj * HALF + n * 16) = o; } }
    }
};
struct EpiSwiglu {
    static constexpr bool PERM = true, AFTER_DRAIN = false;
    bf16_t* O; int ldc;
    __device__ __forceinline__ void operator()(const f32x4 (&acc)[2][2][4][2], const Unit& u, int wr, int wc, int fr, int fq) const {
        const int row0 = u.pm * BM + wr * 64 + fr, col0 = u.pn * HALF + wc * 32 + 8 * fq;
#pragma unroll
        for (int ai = 0; ai < 2; ++ai)
#pragma unroll
            for (int m = 0; m < 4; ++m) { bf16_t* rowp = O + (size_t)(row0 + ai * HALF + m * 16) * ldc + col0;
                float h[8];
#pragma unroll
                for (int n = 0; n < 2; ++n)
#pragma unroll
                    for (int j = 0; j < 4; ++j) { const float g = acc[ai][0][m][n][j], up = acc[ai][1][m][n][j]; h[4 * n + j] = g * fast_sigmoid(g) * up; }
                u32x4 w; w.x = cvt_pk_bf16(h[0], h[1]); w.y = cvt_pk_bf16(h[2], h[3]); w.z = cvt_pk_bf16(h[4], h[5]); w.w = cvt_pk_bf16(h[6], h[7]);
                *(u32x4*)rowp = w; }
    }
};

template <class Epi, class Sched, bool ALIGN_EPI = false, bool SP2 = false>
__device__ __forceinline__ void gemm_phase(PG8_LAS unsigned char* lds, const Gemm g, const Sched& S, const Epi& E, const int wave_id  ) {
    int wid_ = wave_id; asm volatile("" : "+s"(wid_)); const int wid = wid_, lane = fresh_lane(), tid = wid * 64 + lane, wr = wid >> 2, wc = wid & 3, fr = lane & 15, fq = lane >> 4;
    const int K = g.K, nt = K / BK;
    unsigned voffA[2], voffB[2];
#pragma unroll
    for (int i = 0; i < 2; ++i) { int R, C; stage_rc(tid * 16 + i * 8192, R, C); const int Rb = Epi::PERM ? ((R & ~31) + perm32(R & 31)) : R;
        voffA[i] = (unsigned)(R * g.lda + C) * 2u; voffB[i] = (unsigned)(Rb * g.ldb + C) * 2u; }
    const size_t kstep = (size_t)(BK * 2);
    const size_t hstepA = (size_t)HALF * g.lda * 2, hstepB = (size_t)HALF * g.ldb * 2;
    const unsigned ldsw = (unsigned)wid * 1024u;
    const int aoff = lds_byte(wr * 64 + fr, fq * 8), boff = lds_byte(wc * 32 + fr, fq * 8);
#define PG8_SA(b, h) (((b) * 2 + (h)) * HTB)
#define PG8_SB(b, h) ((4 + (b) * 2 + (h)) * HTB)
#define PG8_STAGE(bufoff, gbase, voff) do { _Pragma("unroll") for (int _i = 0; _i < 2; ++_i) \
        __builtin_amdgcn_global_load_lds((const unsigned*)((const char*)(gbase) + (voff)[_i]), (PG8_LAS unsigned*)(lds + (bufoff) + ldsw + _i * 8192), 16, 0, 0); } while (0)
#define PG8_LDA(dst, b, h) do { _Pragma("unroll") for (int m = 0; m < 4; ++m) _Pragma("unroll") for (int k = 0; k < 2; ++k) dst[m][k] = *(const PG8_LAS bf16x8*)(lds + PG8_SA(b, h) + aoff + m * 2048 + k * 1024); } while (0)
#define PG8_LDB(dst, b, h) do { _Pragma("unroll") for (int n = 0; n < 2; ++n) _Pragma("unroll") for (int k = 0; k < 2; ++k) dst[n][k] = *(const PG8_LAS bf16x8*)(lds + PG8_SB(b, h) + boff + n * 2048 + k * 1024); } while (0)
#define PG8_MMA(ai, bj, At, Bt) do { __builtin_amdgcn_s_setprio(1); _Pragma("unroll") for (int m = 0; m < 4; ++m) _Pragma("unroll") for (int n = 0; n < 2; ++n) _Pragma("unroll") for (int k = 0; k < 2; ++k) \
        acc[ai][bj][m][n] = __builtin_amdgcn_mfma_f32_16x16x32_bf16(Bt[n][k], At[m][k], acc[ai][bj][m][n], 0, 0, 0); __builtin_amdgcn_s_setprio(0); } while (0)
#define PG8_WAIT_V(n) asm volatile("s_waitcnt vmcnt(" #n ")" ::: "memory")
#define PG8_WAIT_L(n) asm volatile("s_waitcnt lgkmcnt(" #n ")" ::: "memory")
#define PG8_BAR __builtin_amdgcn_s_barrier()
#define PG8_SCHED __builtin_amdgcn_sched_barrier(0)
    Unit cur, nxt; int ui = 0;
    if (!S.next(0, cur)) return;
    f32x4 acc[2][2][4][2];
#pragma unroll
    for (int a = 0; a < 2; ++a)
#pragma unroll
        for (int b = 0; b < 2; ++b)
#pragma unroll
            for (int m = 0; m < 4; ++m)
#pragma unroll
                for (int n = 0; n < 2; ++n) acc[a][b][m][n] = (f32x4){0.f, 0.f, 0.f, 0.f};
    bf16x8 At[4][2], B0[2][2], B1[2][2];
    const char* cA = (const char*)g.A + cur.aoff; const char* cB = (const char*)g.Bt + cur.boff;
    S.a_ready(cur);
    if constexpr (SP2) {
        PG8_STAGE(PG8_SB(0, 0), cB, voffB); PG8_STAGE(PG8_SB(0, 1), cB + hstepB, voffB); PG8_STAGE(PG8_SA(0, 0), cA, voffA); PG8_STAGE(PG8_SA(0, 1), cA + hstepA, voffA);
        if (wr == 1) PG8_BAR;
        PG8_WAIT_V(2); PG8_BAR;
        PG8_STAGE(PG8_SB(1, 0), cB + kstep, voffB); PG8_STAGE(PG8_SA(1, 0), cA + kstep, voffA); PG8_STAGE(PG8_SB(1, 1), cB + hstepB + kstep, voffB);
        PG8_WAIT_V(6); PG8_BAR;
    } else {
        PG8_STAGE(PG8_SB(0, 0), cB, voffB); PG8_STAGE(PG8_SA(0, 0), cA, voffA); PG8_STAGE(PG8_SB(0, 1), cB + hstepB, voffB); PG8_STAGE(PG8_SA(0, 1), cA + hstepA, voffA);
        if (wr == 1) PG8_BAR;
        PG8_WAIT_V(4); PG8_BAR;
        PG8_STAGE(PG8_SB(1, 0), cB + kstep, voffB); PG8_STAGE(PG8_SA(1, 0), cA + kstep, voffA); PG8_STAGE(PG8_SB(1, 1), cB + hstepB + kstep, voffB);
        PG8_WAIT_V(6); PG8_BAR;
    }
    for (;;) {
        const bool has_next = S.next(ui + 1, nxt);
        const char* nA = has_next ? (const char*)g.A + nxt.aoff : cA; const char* nB = has_next ? (const char*)g.Bt + nxt.boff : cB;
        for (int t = 0; t < nt; t += 2) {
            const bool last = (t == nt - 2);
            const char* a1 = cA + (size_t)(t + 1) * kstep;
            const char* a2 = last ? nA : cA + (size_t)(t + 2) * kstep; const char* b2 = last ? nB : cB + (size_t)(t + 2) * kstep;
            const char* a3 = a2 + kstep; const char* b3 = b2 + kstep;
            if (last && has_next) S.a_ready(nxt);
            if constexpr (SP2) {
            PG8_LDB(B0, 0, 0); PG8_LDB(B1, 0, 1); PG8_SCHED; PG8_LDA(At, 0, 0); PG8_STAGE(PG8_SA(1, 1), a1 + hstepA, voffA);
            PG8_WAIT_V(8); PG8_WAIT_L(0); PG8_BAR; PG8_MMA(0, 0, At, B0); PG8_MMA(0, 1, At, B1); PG8_BAR; PG8_SCHED;
            PG8_LDA(At, 0, 1); PG8_STAGE(PG8_SB(0, 0), b2, voffB); PG8_STAGE(PG8_SB(0, 1), b2 + hstepB, voffB); PG8_STAGE(PG8_SA(0, 0), a2, voffA);
            PG8_WAIT_V(8); PG8_WAIT_L(0); PG8_BAR; PG8_MMA(1, 0, At, B0); PG8_MMA(1, 1, At, B1); PG8_BAR; PG8_SCHED;
            PG8_LDB(B0, 1, 0); PG8_LDB(B1, 1, 1); PG8_SCHED; PG8_LDA(At, 1, 0); PG8_STAGE(PG8_SA(0, 1), a2 + hstepA, voffA);
            PG8_WAIT_V(8); PG8_WAIT_L(0); PG8_BAR; PG8_MMA(0, 0, At, B0); PG8_MMA(0, 1, At, B1); PG8_BAR; PG8_SCHED;
            PG8_LDA(At, 1, 1); PG8_STAGE(PG8_SB(1, 0), b3, voffB); PG8_STAGE(PG8_SB(1, 1), b3 + hstepB, voffB); PG8_STAGE(PG8_SA(1, 0), a3, voffA);
            PG8_WAIT_V(8); PG8_WAIT_L(0); PG8_BAR; PG8_MMA(1, 0, At, B0); PG8_MMA(1, 1, At, B1); PG8_BAR; PG8_SCHED;
            } else {
            PG8_LDB(B0, 0, 0); PG8_SCHED; PG8_LDA(At, 0, 0); PG8_STAGE(PG8_SA(1, 1), a1 + hstepA, voffA);
            PG8_WAIT_L(8); PG8_BAR; PG8_WAIT_L(0); PG8_MMA(0, 0, At, B0); PG8_BAR; PG8_SCHED;
            PG8_LDB(B1, 0, 1); PG8_STAGE(PG8_SB(0, 0), b2, voffB);
            PG8_BAR; PG8_WAIT_L(0); PG8_MMA(0, 1, At, B1); PG8_BAR;
            PG8_LDA(At, 0, 1); PG8_STAGE(PG8_SA(0, 0), a2, voffA);
            PG8_BAR; PG8_WAIT_L(0); PG8_MMA(1, 0, At, B0); PG8_BAR; PG8_SCHED;
            PG8_STAGE(PG8_SB(0, 1), b2 + hstepB, voffB);
            PG8_WAIT_V(6); PG8_BAR; PG8_MMA(1, 1, At, B1); PG8_BAR;
            PG8_LDB(B0, 1, 0); PG8_SCHED; PG8_LDA(At, 1, 0); PG8_STAGE(PG8_SA(0, 1), a2 + hstepA, voffA);
            PG8_WAIT_L(8); PG8_BAR; PG8_WAIT_L(0); PG8_MMA(0, 0, At, B0); PG8_BAR; PG8_SCHED;
            PG8_LDB(B1, 1, 1); PG8_STAGE(PG8_SB(1, 0), b3, voffB);
            PG8_BAR; PG8_WAIT_L(0); PG8_MMA(0, 1, At, B1); PG8_BAR;
            PG8_LDA(At, 1, 1); PG8_STAGE(PG8_SA(1, 0), a3, voffA);
            PG8_BAR; PG8_WAIT_L(0); PG8_MMA(1, 0, At, B0); PG8_BAR; PG8_SCHED;
            PG8_STAGE(PG8_SB(1, 1), b3 + hstepB, voffB);
            PG8_WAIT_V(6); PG8_BAR; PG8_MMA(1, 1, At, B1); PG8_BAR;
            }
        }
        if constexpr (ALIGN_EPI) { if (wr == 0) PG8_BAR; }
        if constexpr (!Epi::AFTER_DRAIN) { const int le = fresh_lane(); E(acc, cur, wr, wc, le & 15, le >> 4); S.done(cur); }
        if (!has_next) break;
#pragma unroll
        for (int a = 0; a < 2; ++a)
#pragma unroll
            for (int b = 0; b < 2; ++b)
#pragma unroll
                for (int m = 0; m < 4; ++m)
#pragma unroll
                    for (int n = 0; n < 2; ++n) acc[a][b][m][n] = (f32x4){0.f, 0.f, 0.f, 0.f};
        cur = nxt; cA = nA; cB = nB; ++ui;
        if constexpr (ALIGN_EPI) { if (wr == 1) PG8_BAR; }
    }
    PG8_WAIT_V(0);
    if constexpr (!ALIGN_EPI) { if (wr == 0) PG8_BAR; }
    PG8_BAR;
    if constexpr (Epi::AFTER_DRAIN) { E.fused(acc, cur, wr, wc, fr, fq, lds, wid, lane); S.done(cur); }
#undef PG8_SA
#undef PG8_SB
#undef PG8_STAGE
#undef PG8_LDA
#undef PG8_LDB
#undef PG8_MMA
#undef PG8_WAIT_V
#undef PG8_WAIT_L
#undef PG8_BAR
#undef PG8_SCHED
}
}
#include <hip/hip_bf16.h>
#include <cmath>
namespace attn_body {
using bf16=__hip_bfloat16;
using bf16x8=__attribute__((ext_vector_type(8)))short;
using s16x4=__attribute__((ext_vector_type(4)))short;
using f32x16=__attribute__((ext_vector_type(16)))float;
using u32x4=__attribute__((ext_vector_type(4)))unsigned;
using f32x4=__attribute__((ext_vector_type(4)))float;
constexpr int BATCH=8,NHEAD=16,SEQ=2048,D=64,DM=NHEAD*D;
constexpr int NW=8,QBLK=32,QB=QBLK*NW,KVBLK=64,NQB=SEQ/QB;
constexpr int ATTN_PITCH=DM, ATTN_UNIT_ROWS=QB;
__device__ __forceinline__ int crow(int r,int hi){return (r&3)+8*(r>>2)+4*hi;}
#define SBAR() __builtin_amdgcn_sched_barrier(0)
__device__ __forceinline__ void cmask(f32x16&p0,f32x16&p1,int jb,int qrel,int hi){
  const float NEG=-INFINITY; int kb=64*jb+4*hi;
  #pragma unroll
  for(int r=0;r<16;++r){int kv=kb+(r&3)+8*(r>>2); if(kv>qrel)p0[r]=NEG; if(kv+32>qrel)p1[r]=NEG;}
}

constexpr int NSLOT=3, SLOTB=8192;
constexpr int LDS_K=0, LDS_V=NSLOT*SLOTB, LDS_WS=2*NSLOT*SLOTB, LDS_OST=LDS_WS+NW*64*4, LDS_F=LDS_OST+NW*4096, LDS_BYTES=LDS_F+SEQ*4;
constexpr float C2=0.125f*1.4426950408889634f;
__device__ __forceinline__ void glds16(const void*gsrc,unsigned lds_dst){unsigned keep;
  asm volatile("s_mov_b32 %0, m0\n\ts_mov_b32 m0, %2\n\ts_nop 0\n\tglobal_load_lds_dwordx4 %1, off\n\ts_mov_b32 m0, %0":"=&s"(keep):"v"(gsrc),"s"(lds_dst):"memory");}
__device__ __forceinline__ float max3f(float a,float b,float c){float r;asm("v_max3_f32 %0, %1, %2, %3":"=v"(r):"v"(a),"v"(b),"v"(c));return r;}
__device__ __forceinline__ float max2f(float a,float b){float r;asm("v_max_f32_e32 %0, %1, %2":"=v"(r):"v"(a),"v"(b));return r;}
__device__ __forceinline__ float fadd_s(float a,float b){float r;asm("v_add_f32_e32 %0, %1, %2":"=v"(r):"v"(a),"v"(b));return r;}
__device__ __forceinline__ float fsub_s(float a,float b){float r;asm("v_sub_f32_e32 %0, %1, %2":"=v"(r):"v"(a),"v"(b));return r;}
typedef float f32x2_t __attribute__((ext_vector_type(2))); typedef __bf16 bf16x2_t __attribute__((ext_vector_type(2)));
__device__ __forceinline__ unsigned cvtpk_s(float lo,float hi){f32x2_t v={lo,hi};bf16x2_t b=__builtin_convertvector(v,bf16x2_t);return __builtin_bit_cast(unsigned,b);}
#define WAIT_BAR(N) asm volatile("s_waitcnt vmcnt(" #N ") lgkmcnt(0)\n\ts_barrier":::"memory")

__device__ __forceinline__ void qkt(f32x16&p0,f32x16&p1,const char*Kslot,const bf16x8*qr,const f32x16&negm,int r32,int hi){
  const char*kb=Kslot+hi*1024+r32*16;
  #pragma unroll
  for(int d0=0;d0<4;++d0){
    const bf16x8 b0=*reinterpret_cast<const bf16x8*>(kb+d0*2048);
    const bf16x8 b1=*reinterpret_cast<const bf16x8*>(kb+d0*2048+512);
    if(d0==0){p0=__builtin_amdgcn_mfma_f32_32x32x16_bf16(b0,qr[0],negm,0,0,0);p1=__builtin_amdgcn_mfma_f32_32x32x16_bf16(b1,qr[0],negm,0,0,0);}
    else{p0=__builtin_amdgcn_mfma_f32_32x32x16_bf16(b0,qr[d0],p0,0,0,0);p1=__builtin_amdgcn_mfma_f32_32x32x16_bf16(b1,qr[d0],p1,0,0,0);}}
}
typedef __attribute__((address_space(3))) const char* lds_cptr;
typedef short v4i16_t __attribute__((ext_vector_type(4)));
__device__ __forceinline__ void kload8(bf16x8*kf,lds_cptr kp){
  kf[0]=*(const __attribute__((address_space(3))) bf16x8*)(kp);      kf[1]=*(const __attribute__((address_space(3))) bf16x8*)(kp+512);
  kf[2]=*(const __attribute__((address_space(3))) bf16x8*)(kp+2048); kf[3]=*(const __attribute__((address_space(3))) bf16x8*)(kp+2560);
  kf[4]=*(const __attribute__((address_space(3))) bf16x8*)(kp+4096); kf[5]=*(const __attribute__((address_space(3))) bf16x8*)(kp+4608);
  kf[6]=*(const __attribute__((address_space(3))) bf16x8*)(kp+6144); kf[7]=*(const __attribute__((address_space(3))) bf16x8*)(kp+6656);
}
__device__ __forceinline__ void kload2(bf16x8*kf,lds_cptr kp,int j){ kf[2*j]=*(const __attribute__((address_space(3))) bf16x8*)(kp+j*2048); kf[2*j+1]=*(const __attribute__((address_space(3))) bf16x8*)(kp+j*2048+512); }
__device__ __forceinline__ s16x4 vtr(lds_cptr p){ return __builtin_bit_cast(s16x4,__builtin_amdgcn_ds_read_tr16_b64_v4i16((__attribute__((address_space(3))) v4i16_t*)p)); }
__device__ __forceinline__ float rowmax(const f32x16&p0,const f32x16&p1){
  float a=max3f(p0[0],p0[1],p1[0]),b=max3f(p0[2],p0[3],p1[1]);a=max3f(a,p1[2],p1[3]);
  #pragma unroll
  for(int r=4;r<16;r+=4){a=max3f(a,p0[r],p0[r+1]);b=max3f(b,p0[r+2],p0[r+3]);a=max3f(a,p1[r],p1[r+1]);b=max3f(b,p1[r+2],p1[r+3]);}
  const float m=max2f(a,b);
  auto rr=__builtin_amdgcn_permlane32_swap(__float_as_uint(m),__float_as_uint(m),false,false);
  return max2f(__uint_as_float(rr[0]),__uint_as_float(rr[1]));
}
__device__ __forceinline__ void pv(f32x16*o,int vb,bf16x8 pa0,bf16x8 pa1,bf16x8 pa2,bf16x8 pa3){
  #pragma unroll
  for(int d0=0;d0<2;++d0){s16x4 lo[4],hi[4];
    #pragma unroll
    for(int ks=0;ks<4;++ks){
      asm volatile("ds_read_b64_tr_b16 %0,%1 offset:%c2":"=&v"(lo[ks]):"v"(vb),"i"(d0*4096+ks*1024):"memory");
      asm volatile("ds_read_b64_tr_b16 %0,%1 offset:%c2":"=&v"(hi[ks]):"v"(vb),"i"(d0*4096+ks*1024+512):"memory");}
    asm volatile("s_waitcnt lgkmcnt(0)":::"memory");SBAR();
    #define PK(k) (bf16x8){lo[k][0],lo[k][1],lo[k][2],lo[k][3],hi[k][0],hi[k][1],hi[k][2],hi[k][3]}
    o[d0]=__builtin_amdgcn_mfma_f32_32x32x16_bf16(pa0,PK(0),o[d0],0,0,0);
    o[d0]=__builtin_amdgcn_mfma_f32_32x32x16_bf16(pa1,PK(1),o[d0],0,0,0);
    o[d0]=__builtin_amdgcn_mfma_f32_32x32x16_bf16(pa2,PK(2),o[d0],0,0,0);
    o[d0]=__builtin_amdgcn_mfma_f32_32x32x16_bf16(pa3,PK(3),o[d0],0,0,0);
    #undef PK
  }
}

#ifndef ATTN_STORE16
#define ATTN_STORE16(p,v) (*(u32x4*)(p)=(v))
#endif
template<int THRL> __device__ __forceinline__ void attn_unit(int b,int h,int qb,const bf16*Q,const bf16*__restrict__ K,const bf16*__restrict__ V,bf16*O,const float*__restrict__ F2,char*shm,const int wave_id){
  int lane_; asm volatile("v_mbcnt_lo_u32_b32 %0, -1, 0\n\tv_mbcnt_hi_u32_b32 %0, -1, %0":"=v"(lane_)); int wid_=wave_id; asm volatile("":"+s"(wid_)); const int wid=wid_,lane=lane_,tid=wid*64+lane,r32=lane&31,hi=lane>>5;
  const long rowbase=(long)b*SEQ; const int q0=qb*QB;
  const bf16*Qw=Q+(rowbase+q0+wid*QBLK)*DM+h*D;
  const bf16*Kh=K+rowbase*DM+h*D,*Vh=V+rowbase*DM+h*D;
  const unsigned lds0=(unsigned)(uintptr_t)shm;
  float*wsf=(float*)(shm+LDS_WS)+wid*64;
  const bf16*ksrc=Kh+(long)lane*DM+wid*8;
  const bf16*vsrc=Vh+(long)(16*(wid&3)+(lane>>2))*DM+(wid>>2)*32+(lane&3)*8;
  const unsigned kdst=lds0+LDS_K+wid*1024, vdst=lds0+LDS_V+wid*1024;
  #define DMA_K(t,slot) glds16(ksrc+(long)(t)*KVBLK*DM,(unsigned)__builtin_amdgcn_readfirstlane(kdst+(slot)))
  #define DMA_V(t,slot) glds16(vsrc+(long)(t)*KVBLK*DM,(unsigned)__builtin_amdgcn_readfirstlane(vdst+(slot)))
  const int vb0=(int)(lds0+LDS_V)+((lane>>4)&1)*32+(lane&3)*8+(4*hi+((lane&15)>>2))*64;
  const char*Kbase=shm+LDS_K; bf16x8 kf[8];
  const lds_cptr shm3=(lds_cptr)shm; const lds_cptr kp0=shm3+LDS_K+hi*1024+r32*16; const lds_cptr vp0=shm3+LDS_V+((lane>>4)&1)*32+(lane&3)*8+(4*hi+((lane&15)>>2))*64;
  const int NT=(q0+QB)/KVBLK;
  __attribute__((address_space(3))) float*const fl=(__attribute__((address_space(3))) float*)shm+LDS_F/4;
  { const int nf4=(q0+QB)/4; for(int i=tid;i<nf4;i+=NW*64){ const f32x4 v=*reinterpret_cast<const f32x4*>(F2+4*i); *reinterpret_cast<__attribute__((address_space(3))) f32x4*>(fl+4*i)=v; } }
  DMA_K(0,0);DMA_V(0,0);DMA_K(1,SLOTB);
  bf16x8 qr[4];
  #pragma unroll
  for(int d0=0;d0<4;++d0)qr[d0]=*reinterpret_cast<const bf16x8*>(&Qw[(long)r32*DM+d0*16+hi*8]);
  float mhat=0.f,l_reg=0.f;f32x16 o[2];o[0]=f32x16{};o[1]=f32x16{};f32x16 negm=f32x16{};asm volatile("":"+v"(negm));
  const int qrel=wid*QBLK+r32;
  #define FBIAS(P0,P1,t) do{ const __attribute__((address_space(3))) f32x4*fp_=(const __attribute__((address_space(3))) f32x4*)fl+16*(t)+hi; \
    _Pragma("unroll") for(int g_=0;g_<4;++g_){ const f32x4 fa_=fp_[2*g_],fb_=fp_[8+2*g_]; \
      P0[4*g_]-=fa_[0];P0[4*g_+1]-=fa_[1];P0[4*g_+2]-=fa_[2];P0[4*g_+3]-=fa_[3];P1[4*g_]-=fb_[0];P1[4*g_+1]-=fb_[1];P1[4*g_+2]-=fb_[2];P1[4*g_+3]-=fb_[3]; } }while(0)
  #define CMASK(P0,P1,t) do{int jb_=(t)-(NT-4); if(jb_>=0)cmask(P0,P1,jb_,qrel,hi);}while(0)
  bool resc=false;
  #define START(P0,P1) do{ const float rm=rowmax(P0,P1); resc=false; \
    { const float dl=rm; mhat=fadd_s(mhat,dl); \
      _Pragma("unroll") for(int r=0;r<16;++r){P0[r]=fsub_s(P0[r],dl);P1[r]=fsub_s(P1[r],dl);} \
      _Pragma("unroll") for(int r=0;r<16;++r)negm[r]=-mhat; asm volatile("":"+v"(negm)); } \
    _Pragma("unroll") for(int r=0;r<16;++r)P0[r]=__builtin_amdgcn_exp2f(P0[r]); }while(0)
  #define RESC() do{ if(resc){ asm volatile("s_waitcnt lgkmcnt(0)":::"memory"); \
      _Pragma("unroll") for(int d_=0;d_<2;++d_) _Pragma("unroll") for(int r=0;r<16;++r)o[d_][r]*=wsf[crow(r,hi)]; } }while(0)
  f32x16 pA0,pA1,pB0,pB1;
  int sl_prev=0,sl_cur=0,sl_next=SLOTB;
  #define ROT() do{sl_prev=sl_cur;sl_cur=sl_next;sl_next=(sl_next==(NSLOT-1)*SLOTB)?0:sl_next+SLOTB;}while(0)
  DMA_K(2,2*SLOTB);
  WAIT_BAR(3);
  { const float Fq=fl[q0+qrel]; mhat=-Fq; _Pragma("unroll") for(int r=0;r<16;++r)negm[r]=Fq; asm volatile("":"+v"(negm)); }
  qkt(pA0,pA1,Kbase,qr,negm,r32,hi);asm volatile("s_nop 15\n\ts_nop 7":"+v"(pA0),"+v"(pA1));FBIAS(pA0,pA1,0);CMASK(pA0,pA1,0);
  START(pA0,pA1);
  _Pragma("unroll") for(int r=0;r<16;++r)pA1[r]=__builtin_amdgcn_exp2f(pA1[r]);
  WAIT_BAR(0);
  DMA_K(3,0);DMA_V(1,SLOTB);
  ROT();
  kload8(kf,kp0+sl_cur);
  WAIT_BAR(2);
  s16x4 vlo[8],vhi[8]; u32x4 pw0,pw1,pw2,pw3;
  #define PKW(P,B) cvtpk_s(P[B],P[B+1])
  #define PAF(k) __builtin_bit_cast(bf16x8,pw##k)
  #define VFR(i) (bf16x8){vlo[i][0],vlo[i][1],vlo[i][2],vlo[i][3],vhi[i][0],vhi[i][1],vhi[i][2],vhi[i][3]}
  #define PIN(x) asm volatile("":"+v"(x))
  #define MX3(a,b,c) __builtin_fmaxf(__builtin_fmaxf((a),(b)),(c))
  #define GAPA(MF,A0,A1,A2,A3,W0,W1,PW) do{ MF; sacc+=A0; sacc+=A1; sacc+=A2; sacc+=A3; PIN(sacc); W0; W1; PIN(PW); SBAR(); }while(0)
  #define EX(v) __builtin_amdgcn_exp2f(v)
  #define GAPB(MF,X,B) do{ MF; X[B]=EX(X[B]); X[B+1]=EX(X[B+1]); X[B+2]=EX(X[B+2]); X[B+3]=EX(X[B+3]); PIN(X); SBAR(); }while(0)
  #define VRD(i) do{ vlo[i]=vtr(vp_+(((i)>>2)*4096+((i)&3)*1024)); vhi[i]=vtr(vp_+(((i)>>2)*4096+((i)&3)*1024+512)); }while(0)
  #define KRD(G,j) do{ if(G){ kload2(kf,kp0+sl_next,j); SBAR(); } }while(0)
  #define STEP(C0,C1,P0,P1,t,GK,GV,GL) do{ SBAR(); \
    const lds_cptr vp_=vp0+sl_prev; \
    VRD(0); SBAR(); float sacc=(P0[0]+P0[1]); \
    GAPA(C0=__builtin_amdgcn_mfma_f32_32x32x16_bf16(kf[0],qr[0],negm,0,0,0), P0[2],P0[3],P0[4],P0[5],     pw0[0]=PKW(P0,0), pw0[1]=PKW(P0,2), pw0); \
    VRD(4); SBAR(); GAPA(C1=__builtin_amdgcn_mfma_f32_32x32x16_bf16(kf[1],qr[0],negm,0,0,0), P0[6],P0[7],P0[8],P0[9],     pw0[2]=PKW(P0,4), pw0[3]=PKW(P0,6), pw0); \
    VRD(1); SBAR(); GAPA(C0=__builtin_amdgcn_mfma_f32_32x32x16_bf16(kf[2],qr[1],C0,0,0,0),   P0[10],P0[11],P0[12],P0[13], pw1[0]=PKW(P0,8), pw1[1]=PKW(P0,10), pw1); \
    VRD(5); SBAR(); GAPA(C1=__builtin_amdgcn_mfma_f32_32x32x16_bf16(kf[3],qr[1],C1,0,0,0),   P0[14],P0[15],P1[0],P1[1],   pw1[2]=PKW(P0,12),pw1[3]=PKW(P0,14), pw1); \
    VRD(2); SBAR(); GAPA(C0=__builtin_amdgcn_mfma_f32_32x32x16_bf16(kf[4],qr[2],C0,0,0,0),   P1[2],P1[3],P1[4],P1[5],     pw2[0]=PKW(P1,0), pw2[1]=PKW(P1,2), pw2); \
    VRD(6); SBAR(); GAPA(C1=__builtin_amdgcn_mfma_f32_32x32x16_bf16(kf[5],qr[2],C1,0,0,0),   P1[6],P1[7],P1[8],P1[9],     pw2[2]=PKW(P1,4), pw2[3]=PKW(P1,6), pw2); \
    VRD(3); SBAR(); GAPA(C0=__builtin_amdgcn_mfma_f32_32x32x16_bf16(kf[6],qr[3],C0,0,0,0),   P1[10],P1[11],P1[12],P1[13], pw3[0]=PKW(P1,8), pw3[1]=PKW(P1,10), pw3); \
    VRD(7); SBAR(); GAPA(C1=__builtin_amdgcn_mfma_f32_32x32x16_bf16(kf[7],qr[3],C1,0,0,0),   P1[14],P1[15],0.f,0.f,       pw3[2]=PKW(P1,12),pw3[3]=PKW(P1,14), pw3); \
    l_reg+=sacc; \
    if(GK){DMA_K((t)+3,sl_cur);} if(GV){DMA_V((t)+1,sl_next);} \
    FBIAS(C0,C1,t); CMASK(C0,C1,t); \
    { float a=MX3(C0[0],C0[1],C1[0]),b=MX3(C0[2],C0[3],C1[1]); a=MX3(a,C1[2],C1[3]); \
      _Pragma("unroll") for(int r=4;r<16;r+=4){a=MX3(a,C0[r],C0[r+1]);b=MX3(b,C0[r+2],C0[r+3]);a=MX3(a,C1[r],C1[r+1]);b=MX3(b,C1[r+2],C1[r+3]);} \
      float rm=__builtin_fmaxf(a,b); { auto rr=__builtin_amdgcn_permlane32_swap(__float_as_uint(rm),__float_as_uint(rm),false,false); rm=__builtin_fmaxf(__uint_as_float(rr[0]),__uint_as_float(rr[1])); } \
      resc=false; \
      if(__builtin_expect(__any(rm>(float)THRL),0)){ const float dl=__builtin_fmaxf(rm,0.f); mhat+=dl; \
        _Pragma("unroll") for(int r=0;r<16;++r){C0[r]-=dl;C1[r]-=dl;} \
        _Pragma("unroll") for(int r=0;r<16;++r)negm[r]=-mhat; asm volatile("":"+v"(negm)); \
        const float f=__builtin_amdgcn_exp2f(-dl); l_reg*=f; if(hi==0)wsf[r32]=f; resc=true; } } \
    SBAR(); \
    GAPB(o[0]=__builtin_amdgcn_mfma_f32_32x32x16_bf16(PAF(0),VFR(0),o[0],0,0,0), C0,0); \
    GAPB(o[1]=__builtin_amdgcn_mfma_f32_32x32x16_bf16(PAF(0),VFR(4),o[1],0,0,0), C0,4); \
    KRD(GL,0); GAPB(o[0]=__builtin_amdgcn_mfma_f32_32x32x16_bf16(PAF(1),VFR(1),o[0],0,0,0), C0,8); \
    KRD(GL,1); GAPB(o[1]=__builtin_amdgcn_mfma_f32_32x32x16_bf16(PAF(1),VFR(5),o[1],0,0,0), C0,12); \
    KRD(GL,2); GAPB(o[0]=__builtin_amdgcn_mfma_f32_32x32x16_bf16(PAF(2),VFR(2),o[0],0,0,0), C1,0); \
    KRD(GL,3); GAPB(o[1]=__builtin_amdgcn_mfma_f32_32x32x16_bf16(PAF(2),VFR(6),o[1],0,0,0), C1,4); \
    GAPB(o[0]=__builtin_amdgcn_mfma_f32_32x32x16_bf16(PAF(3),VFR(3),o[0],0,0,0), C1,8); \
    GAPB(o[1]=__builtin_amdgcn_mfma_f32_32x32x16_bf16(PAF(3),VFR(7),o[1],0,0,0), C1,12); \
    }while(0)
  int t=1;
  #undef CMASK
  #define CMASK(P0,P1,t) do{}while(0)
  for(;t+5<NT;t+=2){
    STEP(pB0,pB1,pA0,pA1,t,true,true,true);     WAIT_BAR(2); RESC(); ROT();
    STEP(pA0,pA1,pB0,pB1,t+1,true,true,true);   WAIT_BAR(2); RESC(); ROT();
  }
  #undef CMASK
  #define CMASK(P0,P1,t) do{int jb_=(t)-(NT-4); if(jb_>=0)cmask(P0,P1,jb_,qrel,hi);}while(0)
  #define ENDW(tt) do{ if((tt)+3<NT){WAIT_BAR(2);} else if((tt)+2<NT){WAIT_BAR(1);} else {WAIT_BAR(0);} }while(0)
  for(;t+1<NT;t+=2){
    STEP(pB0,pB1,pA0,pA1,t,(t+3<NT),(t+1<NT),(t+1<NT));       ENDW(t);   RESC(); ROT();
    STEP(pA0,pA1,pB0,pB1,t+1,(t+4<NT),(t+2<NT),(t+2<NT));     ENDW(t+1); RESC(); ROT();
  }
  STEP(pB0,pB1,pA0,pA1,NT-1,false,false,false); RESC();
  { float sacc=pB0[0]+pB0[1]; _Pragma("unroll") for(int r=2;r<16;++r)sacc+=pB0[r]; _Pragma("unroll") for(int r=0;r<16;++r)sacc+=pB1[r]; l_reg+=sacc;
    pw0=(u32x4){PKW(pB0,0),PKW(pB0,2),PKW(pB0,4),PKW(pB0,6)};pw1=(u32x4){PKW(pB0,8),PKW(pB0,10),PKW(pB0,12),PKW(pB0,14)};pw2=(u32x4){PKW(pB1,0),PKW(pB1,2),PKW(pB1,4),PKW(pB1,6)};pw3=(u32x4){PKW(pB1,8),PKW(pB1,10),PKW(pB1,12),PKW(pB1,14)};
    SBAR(); pv(o,vb0+sl_cur,PAF(0),PAF(1),PAF(2),PAF(3)); }
  #undef PKW
  #undef PAF
  #undef VFR
  #undef PIN
  #undef MX3
  #undef GAPA
  #undef GAPB
  #undef EX
  #undef VRD
  #undef KRD
  #undef STEP
  #undef ENDW
  {auto rr=__builtin_amdgcn_permlane32_swap(__float_as_uint(l_reg),__float_as_uint(l_reg),false,false);l_reg=__uint_as_float(rr[0])+__uint_as_float(rr[1]);}
  if(hi==0)wsf[32+r32]=l_reg;asm volatile("s_waitcnt lgkmcnt(0)":::"memory");
  float rli[16];
  #pragma unroll
  for(int r=0;r<16;++r)rli[r]=__builtin_amdgcn_rcpf(wsf[32+crow(r,hi)]);
  bf16*Ow=O+(rowbase+q0+wid*QBLK)*DM+h*D;
  { bf16*stg=(bf16*)(shm+LDS_OST)+wid*2048;
    #pragma unroll
    for(int r=0;r<16;++r){const int orow=crow(r,hi);
      #pragma unroll
      for(int d0=0;d0<2;++d0)stg[orow*64+d0*32+r32]=__float2bfloat16(o[d0][r]*rli[r]);}
    asm volatile("s_waitcnt lgkmcnt(0)":::"memory");
    #pragma unroll
    for(int i=0;i<4;++i){const int row=i*8+(lane>>3),ch=lane&7; const u32x4 v=*(const u32x4*)(stg+row*64+ch*8); ATTN_STORE16(Ow+(long)row*DM+ch*8,v);} }
  asm volatile("s_waitcnt lgkmcnt(0)\n\ts_barrier":::"memory");
  #undef DMA_K
  #undef DMA_V
  #undef CMASK
  #undef FBIAS
  #undef START
  #undef RESC
  #undef ROT
}
constexpr int ATTN_LDS_BYTES=LDS_BYTES;
struct AttnTensors { const bf16* Q; const bf16* K; const bf16* V; bf16* O; const float* F2; };
struct AttnUnit { int bh; int qb; };
struct StaticOrder {
  int vcu,G;
  __device__ __forceinline__ StaticOrder(int grid,int vcu_):vcu(vcu_),G(grid){}
  __device__ __forceinline__ bool next(int i,AttnUnit&u)const{ const int p=vcu+(i>>1)*G; if(p>=BATCH*NHEAD*NQB/2)return false; const int s=p%(NQB/2); u.bh=p/(NQB/2); u.qb=(i&1)?(NQB-1-s):s; return true; }
  __device__ __forceinline__ void a_ready(const AttnUnit&)const{}
  __device__ __forceinline__ void done(const AttnUnit&)const{}
};
template<class Sched,int THRL=8> __device__ __forceinline__ void attn_phase(char*lds,const AttnTensors&T,const Sched&S,const int wave_id){
  AttnUnit u;
  for(int i=0;S.next(i,u);++i){ S.a_ready(u); attn_unit<THRL>(u.bh/NHEAD,u.bh%NHEAD,u.qb,T.Q,T.K,T.V,T.O,T.F2+(size_t)u.bh*SEQ,lds,wave_id); S.done(u); }
}
#undef SBAR
#undef WAIT_BAR
}
#define GAS __attribute__((address_space(1)))
#define LAS __attribute__((address_space(3)))
typedef unsigned short bf16;
typedef unsigned v4u __attribute__((ext_vector_type(4)));
typedef float f32x4 __attribute__((ext_vector_type(4)));
typedef short bf16x8 __attribute__((ext_vector_type(8)));
typedef GAS unsigned gu32;
typedef GAS unsigned long long gu64;
#define RLX_AGENT __ATOMIC_RELAXED, __HIP_MEMORY_SCOPE_AGENT
#define LDS_WAIT() asm volatile("s_waitcnt lgkmcnt(0)" ::: "memory")
#define VM_WAIT() asm volatile("s_waitcnt vmcnt(0)" ::: "memory")
__device__ __forceinline__ unsigned long long rt() { return __builtin_amdgcn_s_memrealtime(); }
__device__ __forceinline__ unsigned f2bf(float f) { unsigned u = __builtin_bit_cast(unsigned, f); return (u + 0x7fffu + ((u >> 16) & 1u)) >> 16; }
__device__ __forceinline__ unsigned pk2(float lo, float hi) { return f2bf(lo) | (f2bf(hi) << 16); }

#define XB_TMO      128
#define XB_XCNT(j)  (256  + 64 * (j))
#define XB_XSUB(j)  (1280 + 64 * (j))
#define XB_XGEN(j)  (2304 + 64 * (j))
#define XB_TOP      3328
#define XB_TOPGEN   3392
#define XCD_BAR_WORDS 3456
#define XB_SPIN_CAP (1u << 18)

__device__ __forceinline__ unsigned xb_ld(unsigned* p)              { return __hip_atomic_load(p, __ATOMIC_RELAXED, __HIP_MEMORY_SCOPE_AGENT); }
__device__ __forceinline__ unsigned xb_add(unsigned* p, unsigned v) { return __hip_atomic_fetch_add(p, v, __ATOMIC_RELAXED, __HIP_MEMORY_SCOPE_AGENT); }
__device__ __forceinline__ unsigned xb_xcc_id() { return (unsigned)__builtin_amdgcn_s_getreg((3 << 11) | 20) & 0xFu; }
#define XB_SPIN(cond, bar) do { unsigned _sp = 0; while (cond) { __builtin_amdgcn_s_sleep(1); \
    if ((++_sp & 255u) == 0u) { if (xb_ld(&(bar)[XB_TMO])) break; if (_sp > XB_SPIN_CAP) { atomicAdd(&(bar)[XB_TMO], 1u); break; } } } } while (0)

struct XcdBarrier {
    unsigned* bar; unsigned x; unsigned wave;
    volatile LAS unsigned* st;
};

__device__ __forceinline__ XcdBarrier xcd_barrier_post(unsigned* bar, volatile LAS unsigned* st) {
    XcdBarrier b; b.bar = bar; b.x = xb_xcc_id(); b.st = st; b.wave = threadIdx.x >> 6;
    if (threadIdx.x == 0) (void)xb_add(&bar[XB_XCNT(b.x)], 1u);
    return b;
}
__device__ __forceinline__ void xcd_barrier_complete(unsigned* bar, unsigned x, unsigned& nloc, unsigned& nx, volatile LAS unsigned* st) {
    const unsigned G = st[2];
    unsigned sum, cnt, mine, sp = 0u;
    for (;;) {
        sum = 0u; cnt = 0u; mine = 0u;
#pragma unroll
        for (unsigned j = 0; j < 16; ++j) { const unsigned c = xb_ld(&bar[XB_XCNT(j)]); sum += c; cnt += (c > 0u) ? 1u : 0u; mine = (j == x) ? c : mine; }
        if (sum == G) break;
        __builtin_amdgcn_s_sleep(1);
        if ((++sp & 255u) == 0u) { if (xb_ld(&bar[XB_TMO])) break; if (sp > XB_SPIN_CAP) { atomicAdd(&bar[XB_TMO], 1u); break; } }
    }
    nloc = mine > 0u ? mine : 1u; nx = cnt > 0u ? cnt : 1u;
}

__device__ __forceinline__ void xcd_barrier(const XcdBarrier& b) {
    asm volatile("s_waitcnt vmcnt(0)" ::: "memory");
    __syncthreads();
    unsigned l0_; asm volatile("v_mbcnt_lo_u32_b32 %0, -1, 0\n\tv_mbcnt_hi_u32_b32 %0, -1, %0" : "=v"(l0_));
    if (b.wave == 0u && l0_ == 0u) {
        unsigned* bar = b.bar;
        __builtin_amdgcn_s_waitcnt(0);
        unsigned nloc = b.st[0], nx = b.st[1];
        if (nloc == 0u) { xcd_barrier_complete(bar, b.x, nloc, nx, b.st); b.st[0] = nloc; b.st[1] = nx; }
        const unsigned old = xb_add(&bar[XB_XSUB(b.x)], 1u);
        const unsigned gen = old / nloc;
        if (old + 1u == (gen + 1u) * nloc) {
            __builtin_amdgcn_fence(__ATOMIC_RELEASE, "agent");
            asm volatile("s_waitcnt vmcnt(0)" ::: "memory");
            const unsigned og = xb_add(&bar[XB_TOP], 1u);
            const unsigned tg = og / nx;
            if (og + 1u == (tg + 1u) * nx) xb_add(&bar[XB_TOPGEN], 1u);
            else XB_SPIN(xb_ld(&bar[XB_TOPGEN]) == tg, bar);
            __builtin_amdgcn_fence(__ATOMIC_ACQUIRE, "agent");
            xb_add(&bar[XB_XGEN(b.x)], 1u);
            asm volatile("s_waitcnt vmcnt(0)" ::: "memory");
        } else {
            XB_SPIN(xb_ld(&bar[XB_XGEN(b.x)]) == gen, bar);
            __builtin_amdgcn_fence(__ATOMIC_ACQUIRE, "agent");
            asm volatile("s_waitcnt vmcnt(0)" ::: "memory");
        }
    }
    __syncthreads();
}

constexpr int NWAVES = 8;
#ifndef MK_N_LAUNCHES
#define MK_N_LAUNCHES 1
#endif
constexpr int NPH = 34;
constexpr int N_LAUNCHES = MK_N_LAUNCHES;
static_assert(N_LAUNCHES == 1 || N_LAUNCHES == NPH, "MK_N_LAUNCHES is 1 or 34");

constexpr int NBATCH = 8, SEQ = 2048, T = NBATCH * SEQ, D = 1024, DFF = 3584, NE = 8, NH = 16;
constexpr int MAXBLK = 136;
constexpr float LN_EPS = 1e-5f;
constexpr float ALPHA = 1.6817928305074290f;
constexpr float LOG2E = 1.4426950408889634f;

constexpr size_t MiB = 1u << 20;
constexpr size_t WS_CTL = 0, CTL_ZERO_BYTES = 1 * MiB;
constexpr size_t WS_WIN = 2 * MiB;
constexpr size_t WS_WGATE = 10 * MiB;
constexpr size_t WS_WOUT = 11 * MiB;
constexpr size_t WS_WPOOL = 15 * MiB;
constexpr size_t WS_WQKV = 16 * MiB;
constexpr size_t WS_WO = 22 * MiB;
constexpr size_t WS_WGU = 24 * MiB;
constexpr size_t WS_WDN = 52 * MiB;
constexpr size_t WS_MGU = 66 * MiB;
constexpr size_t WS_MDN = 290 * MiB;
constexpr size_t WS_XF = 402 * MiB;
constexpr size_t WS_XB = 466 * MiB;
constexpr size_t WS_PRE = 498 * MiB;
constexpr size_t WS_S0 = 562 * MiB;
constexpr size_t WS_YG = WS_S0, WS_REC = WS_S0 + 32 * MiB, WS_XR = WS_S0 + 96 * MiB, WS_AA = WS_S0 + 128 * MiB, WS_BB = WS_S0 + 192 * MiB, WS_HY = WS_S0 + 256 * MiB;
constexpr size_t WS_PB = WS_S0;
constexpr size_t WS_Q = WS_S0, WS_K = WS_S0 + 32 * MiB, WS_V = WS_S0 + 64 * MiB;
constexpr size_t WS_HB = WS_S0;
constexpr size_t WS_ROWS = WS_S0, WS_HB2 = WS_S0 + 68 * MiB, WS_YROWS = WS_S0 + 306 * MiB;
constexpr size_t WS_TOK = WS_S0 + 442 * MiB, WS_GATE = WS_TOK + 1 * MiB, WS_DEST = WS_TOK + 2 * MiB, WS_BLKE = WS_TOK + 3 * MiB;
constexpr size_t WS_LOGF = WS_S0 + 446 * MiB, WS_F2 = WS_LOGF + 1 * MiB;
constexpr size_t WS_END = WS_S0 + 448 * MiB;
constexpr int CW_TMO = 0, CW_CODE = 1;
constexpr int CW_BAR = 4096;
constexpr int CW_CNT = 16384;

constexpr int RING_OFF = 0, RING_BYTES = 131072;
constexpr int LDSCTL_OFF = RING_BYTES, MISC_OFF = LDSCTL_OFF + 320;
constexpr int LDS_BYTES = 147456;
static_assert(MISC_OFF + 128 <= LDS_BYTES, "LDS map");

struct Frame {
    LAS unsigned char* lds;
    volatile LAS unsigned* MISC;
    int wave;
    int vcu, G;
};
struct Args { const float* in[22]; float* out; unsigned char* wsbase; int ph_lo, ph_hi; };
static_assert(sizeof(Args) == 24 * 8 + 8, "Args has no padding");
typedef __attribute__((address_space(4))) const Args* KArgs;
__device__ __forceinline__ KArgs kargs() { KArgs p = (KArgs)__builtin_amdgcn_kernarg_segment_ptr(); asm volatile("" : "+s"(p)); return p; }
#define INP(i) (kargs()->in[i])
#define WSP (kargs()->wsbase)
#define CTLP ((gu32*)(WSP + WS_CTL))
typedef float f32x2 __attribute__((ext_vector_type(2)));
typedef int i32x4 __attribute__((ext_vector_type(4)));
typedef int i32x2 __attribute__((ext_vector_type(2)));
typedef unsigned v2u __attribute__((ext_vector_type(2)));
__device__ __forceinline__ unsigned cvtpk(float lo, float hi) { unsigned r; asm volatile("v_cvt_pk_bf16_f32 %0, %1, %2" : "=v"(r) : "v"(lo), "v"(hi)); return r; }
__device__ __forceinline__ float bflo(unsigned w) { return __uint_as_float(w << 16); }
__device__ __forceinline__ float bfhi(unsigned w) { return __uint_as_float(w & 0xffff0000u); }
__device__ __forceinline__ float wave_sum(float v) {
#pragma unroll
    for (int o = 1; o < 64; o <<= 1) v += __shfl_xor(v, o);
    return v;
}

template <bool ILEAVE>
__device__ __forceinline__ void tr_tile(const float* __restrict__ W, int ldw, int K, bf16* WT, int ktile, int ntile, LAS unsigned* scr, int tid) {
    const int k0 = ktile * 128, n0 = ntile * 256, wave = tid >> 6, lane = tid & 63;
    const float* src = W + (size_t)(k0 + wave * 16) * ldw + n0 + lane;
#pragma unroll
    for (int i = 0; i < 8; ++i) {
        float lo[4], hi[4];
#pragma unroll
        for (int j = 0; j < 4; ++j) { lo[j] = src[(size_t)(2 * i) * ldw + 64 * j]; hi[j] = src[(size_t)(2 * i + 1) * ldw + 64 * j]; }
#pragma unroll
        for (int j = 0; j < 4; ++j) scr[(64 * j + lane) * 65 + wave * 8 + i] = cvtpk(lo[j], hi[j]);
    }
    __syncthreads();
#pragma unroll
    for (int it = 0; it < 8; ++it) {
        const int idx = it * 512 + tid, n = idx >> 4, q = idx & 15;
        const LAS unsigned* s = scr + n * 65 + 4 * q;
        v4u o; o.x = s[0]; o.y = s[1]; o.z = s[2]; o.w = s[3];
        int drow = n0 + n;
        if (ILEAVE) { const int part = drow >= DFF ? 1 : 0, j = drow - part * DFF; drow = 256 * (j >> 7) + 128 * part + (j & 127); }
        *(GAS v4u*)(WT + (size_t)drow * K + k0 + 8 * q) = o;
    }
    __syncthreads();
}
__device__ __forceinline__ void p0_prologue(Frame& F) {
    int wave_ = F.wave; asm volatile("" : "+s"(wave_)); const int wave = wave_, lane = pg8::fresh_lane(), tid = wave * 64 + lane; (void)tid;
    LAS unsigned* scr = (LAS unsigned*)(F.lds + RING_OFF);
    unsigned char* ws = WSP;
    constexpr int T_MGU = 8 * 28, T_MDN = 28 * 4, T_GU = 8 * 28, T_DN = 28 * 4, T_IN = 8 * 8, T_OUT = 8 * 4, T_QKV = 8 * 12, T_WO = 8 * 4, T_GATE = 1, T_POOL = 2;
    constexpr int N_MGU = 16 * T_MGU, N_MDN = 16 * T_MDN, N_GU = 2 * T_GU, N_DN = 2 * T_DN, N_IN = 2 * T_IN, N_OUT = 2 * T_OUT, N_GATE = 16 * T_GATE, N_POOL = 4 * T_POOL;
    constexpr int NT_ALL = N_MGU + N_MDN + N_GU + N_DN + N_IN + N_OUT + T_QKV + T_WO + N_GATE + N_POOL;
    for (int it = blockIdx.x; it < NT_ALL; it += F.G) {
        int r = it;
        if (r < N_MGU) { const int m = r / T_MGU, t = r % T_MGU; tr_tile<true>(INP(16) + (size_t)m * D * 2 * DFF, 2 * DFF, D, (bf16*)(ws + WS_MGU) + (size_t)m * 2 * DFF * D, t / 28, t % 28, scr, tid); continue; } r -= N_MGU;
        if (r < N_MDN) { const int m = r / T_MDN, t = r % T_MDN; tr_tile<false>(INP(17) + (size_t)m * DFF * D, D, DFF, (bf16*)(ws + WS_MDN) + (size_t)m * D * DFF, t / 4, t % 4, scr, tid); continue; } r -= N_MDN;
        if (r < N_GU) { const int m = r / T_GU, t = r % T_GU; tr_tile<true>(INP(13) + (size_t)m * D * 2 * DFF, 2 * DFF, D, (bf16*)(ws + WS_WGU) + (size_t)m * 2 * DFF * D, t / 28, t % 28, scr, tid); continue; } r -= N_GU;
        if (r < N_DN) { const int m = r / T_DN, t = r % T_DN; tr_tile<false>(INP(14) + (size_t)m * DFF * D, D, DFF, (bf16*)(ws + WS_WDN) + (size_t)m * D * DFF, t / 4, t % 4, scr, tid); continue; } r -= N_DN;
        if (r < N_IN) { const int m = r / T_IN, t = r % T_IN; tr_tile<false>(INP(1) + (size_t)m * D * 2 * D, 2 * D, D, (bf16*)(ws + WS_WIN) + (size_t)m * 2 * D * D, t / 8, t % 8, scr, tid); continue; } r -= N_IN;
        if (r < N_OUT) { const int m = r / T_OUT, t = r % T_OUT; tr_tile<false>(INP(7) + (size_t)m * D * D, D, D, (bf16*)(ws + WS_WOUT) + (size_t)m * D * D, t / 4, t % 4, scr, tid); continue; } r -= N_OUT;
        if (r < T_QKV) { tr_tile<false>(INP(10), 3 * D + NH, D, (bf16*)(ws + WS_WQKV), r / 12, r % 12, scr, tid); continue; } r -= T_QKV;
        if (r < T_WO) { tr_tile<false>(INP(12), D, D, (bf16*)(ws + WS_WO), r / 4, r % 4, scr, tid); continue; } r -= T_WO;
        if (r < N_GATE) { tr_tile<false>(INP(4) + (size_t)r * 128 * 256, 256, 128, (bf16*)(ws + WS_WGATE) + (size_t)r * 256 * 128, 0, 0, scr, tid); continue; } r -= N_GATE;
        { const int m = r / T_POOL, t = r % T_POOL; tr_tile<false>(INP(8) + (size_t)m * 256 * 256, 256, 256, (bf16*)(ws + WS_WPOOL) + (size_t)m * 256 * 256, t, 0, scr, tid); }
    }
    const GAS f32x4* x4 = (const GAS f32x4*)INP(0); GAS v2u* xb = (GAS v2u*)(ws + WS_XB);
    for (size_t i = (size_t)blockIdx.x * 512 + tid; i < (size_t)T * D / 4; i += (size_t)F.G * 512) { const f32x4 v = x4[i]; v2u o; o.x = cvtpk(v.x, v.y); o.y = cvtpk(v.z, v.w); xb[i] = o; }
}

__device__ __forceinline__ void ln_row(f32x4 (&v)[4], const float* g, const float* b, int lane) {
    float s = 0.f;
#pragma unroll
    for (int j = 0; j < 4; ++j) s += (v[j].x + v[j].y) + (v[j].z + v[j].w);
    const float mean = wave_sum(s) * (1.f / D); float s2 = 0.f;
#pragma unroll
    for (int j = 0; j < 4; ++j) { v[j] = v[j] - mean; s2 += (v[j].x * v[j].x + v[j].y * v[j].y) + (v[j].z * v[j].z + v[j].w * v[j].w); }
    const float rstd = 1.f / sqrtf(wave_sum(s2) * (1.f / D) + LN_EPS);
#pragma unroll
    for (int j = 0; j < 4; ++j) { const f32x4 gg = ((const f32x4*)g)[lane + 64 * j], bb = ((const f32x4*)b)[lane + 64 * j]; v[j] = v[j] * rstd * gg + bb; }
}
__device__ __forceinline__ void store_row(const f32x4 (&v)[4], float* xf_row, bf16* xb_row, int lane) {
#pragma unroll
    for (int j = 0; j < 4; ++j) ((GAS f32x4*)xf_row)[lane + 64 * j] = v[j];
    if (xb_row) {
#pragma unroll
        for (int j = 0; j < 4; ++j) { v2u o; o.x = cvtpk(v[j].x, v[j].y); o.y = cvtpk(v[j].z, v[j].w); ((GAS v2u*)xb_row)[lane + 64 * j] = o; }
    }
}
__device__ __forceinline__ void ln_phase(Frame& F, const float* pre, const float* g, const float* b, float* xf, bf16* xb) {
    int wave_ = F.wave; asm volatile("" : "+s"(wave_)); const int wave = wave_, lane = pg8::fresh_lane(), tid = wave * 64 + lane; (void)tid;
    const int gw = F.vcu * NWAVES + wave, NGW = F.G * NWAVES;
    for (int row = gw; row < T; row += NGW) {
        f32x4 v[4];
#pragma unroll
        for (int j = 0; j < 4; ++j) v[j] = ((const GAS f32x4*)(pre + (size_t)row * D))[lane + 64 * j];
        ln_row(v, g, b, lane);
        store_row(v, xf + (size_t)row * D, xb + (size_t)row * D, lane);
    }
}
__device__ __forceinline__ void ln_router_phase(Frame& F, const float* pre, const float* g, const float* b, float* xf, bf16* xb, const float* wr, gu32* cnt, i32x4* tok, f32x2* gate) {
    int wave_ = F.wave; asm volatile("" : "+s"(wave_)); const int wave = wave_, lane = pg8::fresh_lane(), tid = wave * 64 + lane; (void)tid;
    LAS unsigned* lcnt = (LAS unsigned*)(F.lds + RING_OFF);
    LAS unsigned* lbase = lcnt + 8;
    LAS int* rinfo = (LAS int*)(F.lds + RING_OFF + 256);
    LAS float* rgate = (LAS float*)(F.lds + RING_OFF + 256 + 1024);
    float w[4][4][8];
#pragma unroll
    for (int j = 0; j < 4; ++j)
#pragma unroll
        for (int i = 0; i < 4; ++i) { const f32x4* p = (const f32x4*)(wr + (size_t)(4 * (lane + 64 * j) + i) * NE); const f32x4 a = p[0], c = p[1];
            w[j][i][0] = a.x; w[j][i][1] = a.y; w[j][i][2] = a.z; w[j][i][3] = a.w; w[j][i][4] = c.x; w[j][i][5] = c.y; w[j][i][6] = c.z; w[j][i][7] = c.w; }
    for (int r0 = blockIdx.x * 64; r0 < T; r0 += F.G * 64) {
        if (tid < 8) lcnt[tid] = 0u;
        __syncthreads();
        for (int i8 = 0; i8 < 8; ++i8) {
            const int lr = wave * 8 + i8, row = r0 + lr;
            f32x4 v[4];
#pragma unroll
            for (int j = 0; j < 4; ++j) v[j] = ((const GAS f32x4*)(pre + (size_t)row * D))[lane + 64 * j];
            ln_row(v, g, b, lane);
            store_row(v, xf + (size_t)row * D, xb + (size_t)row * D, lane);
            float lg[8];
#pragma unroll
            for (int e = 0; e < 8; ++e) { float s = 0.f;
#pragma unroll
                for (int j = 0; j < 4; ++j) s += (v[j].x * w[j][0][e] + v[j].y * w[j][1][e]) + (v[j].z * w[j][2][e] + v[j].w * w[j][3][e]);
                lg[e] = wave_sum(s); }
            int e1 = 0; float v1 = lg[0];
#pragma unroll
            for (int e = 1; e < 8; ++e) if (lg[e] > v1) { v1 = lg[e]; e1 = e; }
            int e2 = -1; float v2 = -INFINITY;
#pragma unroll
            for (int e = 0; e < 8; ++e) if (e != e1 && lg[e] > v2) { v2 = lg[e]; e2 = e; }
            if (lane == 0) {
                const float ex = expf(v2 - v1), g1 = 1.f / (1.f + ex), g2 = ex * g1;
                const unsigned s1 = __hip_atomic_fetch_add(lcnt + e1, 1u, __ATOMIC_RELAXED, __HIP_MEMORY_SCOPE_WORKGROUP);
                const unsigned s2 = __hip_atomic_fetch_add(lcnt + e2, 1u, __ATOMIC_RELAXED, __HIP_MEMORY_SCOPE_WORKGROUP);
                rinfo[lr * 4 + 0] = e1; rinfo[lr * 4 + 1] = (int)s1; rinfo[lr * 4 + 2] = e2; rinfo[lr * 4 + 3] = (int)s2; rgate[lr * 2] = g1; rgate[lr * 2 + 1] = g2;
            }
        }
        __syncthreads();
        if (tid < 8) lbase[tid] = __hip_atomic_fetch_add(cnt + 64 * tid, lcnt[tid], RLX_AGENT);
        __syncthreads();
        if (tid < 64) { const int a1 = rinfo[tid * 4], a2 = rinfo[tid * 4 + 2];
            i32x4 o; o.x = a1; o.y = (int)lbase[a1] + rinfo[tid * 4 + 1]; o.z = a2; o.w = (int)lbase[a2] + rinfo[tid * 4 + 3];
            tok[r0 + tid] = o; f32x2 gg; gg.x = rgate[tid * 2]; gg.y = rgate[tid * 2 + 1]; gate[r0 + tid] = gg; }
        __syncthreads();
    }
}
__device__ __forceinline__ void gather_phase(Frame& F, gu32* cnt, const i32x4* tok, const bf16* xb, bf16* rows, i32x2* dest, int* blke) {
    int wave_ = F.wave; asm volatile("" : "+s"(wave_)); const int wave = wave_, lane = pg8::fresh_lane(), tid = wave * 64 + lane; (void)tid;
    int ps[8], pend[8]; int run = 0;
#pragma unroll
    for (int e = 0; e < 8; ++e) { const int c = (int)__hip_atomic_load(cnt + 64 * e, RLX_AGENT); ps[e] = run; run += (c + 255) & ~255; pend[e] = run; }
    const int gw = F.vcu * NWAVES + wave, NGW = F.G * NWAVES;
    for (int row = gw; row < T; row += NGW) {
        const i32x4 tk = tok[row];
        int p1 = ps[0], p2 = ps[0];
#pragma unroll
        for (int e = 1; e < 8; ++e) { p1 = (tk.x == e) ? ps[e] : p1; p2 = (tk.z == e) ? ps[e] : p2; }
        const int d1 = p1 + tk.y, d2 = p2 + tk.w;
        const GAS v4u* s = (const GAS v4u*)(xb + (size_t)row * D);
        const v4u a = s[lane], c = s[lane + 64];
        GAS v4u* o1 = (GAS v4u*)(rows + (size_t)d1 * D); GAS v4u* o2 = (GAS v4u*)(rows + (size_t)d2 * D);
        o1[lane] = a; o1[lane + 64] = c; o2[lane] = a; o2[lane + 64] = c;
        if (lane == 0) { i32x2 dd; dd.x = d1; dd.y = d2; dest[row] = dd; }
    }
    if (blockIdx.x == 0 && tid < MAXBLK) { const int start = tid * 256; int e = 0;
#pragma unroll
        for (int q = 0; q < 8; ++q) e += (pend[q] <= start) ? 1 : 0;
        blke[tid] = e < 7 ? e : 7;
        if (tid == 0) blke[200] = pend[7] / 256; }
}
template <bool FGATE>
__device__ __forceinline__ void combine_ln_phase(Frame& F, const float* xf_in, const float* yrows, const i32x2* dest, const f32x2* gate, const float* g, const float* b, float* xf_out, bf16* xb_out,
                                                  const float* wqkvf, const float* bfg, float* logf) {
    int wave_ = F.wave; asm volatile("" : "+s"(wave_)); const int wave = wave_, lane = pg8::fresh_lane(), tid = wave * 64 + lane; (void)tid;
    LAS float* wfT = (LAS float*)(F.lds + RING_OFF);
    if (FGATE) {
        for (int idx = tid; idx < D * NH; idx += 512) { const int d = idx >> 4, h = idx & 15; wfT[h * D + d] = wqkvf[(size_t)d * (3 * D + NH) + 3 * D + h]; }
        __syncthreads();
    }
    const int gw = F.vcu * NWAVES + wave, NGW = F.G * NWAVES;
    for (int row = gw; row < T; row += NGW) {
        const i32x2 dd = dest[row]; const f32x2 gg = gate[row];
        f32x4 v[4];
#pragma unroll
        for (int j = 0; j < 4; ++j) { const f32x4 x = ((const GAS f32x4*)(xf_in + (size_t)row * D))[lane + 64 * j];
            const f32x4 y1 = ((const GAS f32x4*)(yrows + (size_t)dd.x * D))[lane + 64 * j], y2 = ((const GAS f32x4*)(yrows + (size_t)dd.y * D))[lane + 64 * j];
            v[j] = x * ALPHA + (y1 * gg.x + y2 * gg.y); }
        ln_row(v, g, b, lane);
        store_row(v, xf_out + (size_t)row * D, xb_out ? xb_out + (size_t)row * D : nullptr, lane);
        if (FGATE) {
            float zz = 0.f;
#pragma unroll
            for (int h = 0; h < NH; ++h) { float s = 0.f;
#pragma unroll
                for (int j = 0; j < 4; ++j) { const f32x4 wv = ((const LAS f32x4*)(wfT + h * D))[lane + 64 * j]; s += (v[j].x * wv.x + v[j].y * wv.y) + (v[j].z * wv.z + v[j].w * wv.w); }
                s = wave_sum(s); zz = (lane == h) ? s : zz; }
            if (lane < NH) { const float z = zz + bfg[lane]; logf[(size_t)row * NH + lane] = fminf(z, 0.f) - log1pf(expf(-fabsf(z))); }
        }
    }
    if (FGATE) __syncthreads();
}
__device__ __forceinline__ void poolp_phase(Frame& F, const float* xf, bf16* pb) {
    int wave_ = F.wave; asm volatile("" : "+s"(wave_)); const int wave = wave_, lane = pg8::fresh_lane(), tid = wave * 64 + lane; (void)tid;
    const int gw = F.vcu * NWAVES + wave, NGW = F.G * NWAVES;
    for (int row = gw; row < T; row += NGW) {
        const int pos = row & (SEQ - 1);
        const GAS f32x4* xr = (const GAS f32x4*)(xf + (size_t)row * D) + lane;
#pragma unroll
        for (int j = 0; j < 4; ++j) {
            const int w = 2 << j; const f32x4 x0 = xr[64 * j]; f32x4 s = x0;
#pragma unroll
            for (int k = 1; k < w; ++k) if (k <= pos) s = s + xr[64 * j - (size_t)k * (D / 4)];
            const float cntf = (float)((pos + 1) < w ? (pos + 1) : w);
            const f32x4 p = s / cntf - x0;
            v2u o; o.x = cvtpk(p.x, p.y); o.y = cvtpk(p.z, p.w); ((GAS v2u*)(pb + (size_t)row * D))[lane + 64 * j] = o;
        }
    }
}
__device__ __forceinline__ void conv_phase(Frame& F, const float* rec, const float* cw, const float* cb, bf16* xr) {
    int wave_ = F.wave; asm volatile("" : "+s"(wave_)); const int wave = wave_, lane = pg8::fresh_lane(), tid = wave * 64 + lane; (void)tid;
    const int gw = F.vcu * NWAVES + wave, NGW = F.G * NWAVES;
    f32x4 wk[2][4][2], bk[2][2];
#pragma unroll
    for (int j = 0; j < 2; ++j) { const int c = 8 * lane + 512 * j;
#pragma unroll
        for (int k = 0; k < 4; ++k) { wk[j][k][0] = *(const f32x4*)(cw + k * D + c); wk[j][k][1] = *(const f32x4*)(cw + k * D + c + 4); }
        bk[j][0] = *(const f32x4*)(cb + c); bk[j][1] = *(const f32x4*)(cb + c + 4); }
    for (int row = gw; row < T; row += NGW) {
        const int pos = row & (SEQ - 1);
#pragma unroll
        for (int j = 0; j < 2; ++j) { const int c = 8 * lane + 512 * j;
            f32x4 a0 = bk[j][0], a1 = bk[j][1];
#pragma unroll
            for (int k = 0; k < 4; ++k) { const int d = 3 - k;
                if (pos >= d) { const GAS f32x4* p = (const GAS f32x4*)(rec + (size_t)(row - d) * D + c); a0 = a0 + wk[j][k][0] * p[0]; a1 = a1 + wk[j][k][1] * p[1]; } }
            v4u o; o.x = cvtpk(a0.x, a0.y); o.y = cvtpk(a0.z, a0.w); o.z = cvtpk(a1.x, a1.y); o.w = cvtpk(a1.z, a1.w);
            *(GAS v4u*)(xr + (size_t)row * D + c) = o; }
    }
}
__device__ __forceinline__ void scan_phase(Frame& F, const float* AA, const float* BB, const bf16* YG, bf16* HY) {
    int wave_ = F.wave; asm volatile("" : "+s"(wave_)); const int wave = wave_, lane = pg8::fresh_lane(), tid = wave * 64 + lane; (void)tid;
    LAS float* sA = (LAS float*)(F.lds + RING_OFF); LAS float* sH = sA + 512; LAS float* sC = sH + 512;
    const int k = tid >> 5, ch = tid & 31;
    for (int task = blockIdx.x; task < 256; task += F.G) {
        const int bb = task >> 5, c0 = (task & 31) * 32;
        const size_t base = ((size_t)(bb * SEQ + k * 128)) * D + c0 + ch;
        float A = 1.f, Hh = 0.f;
#pragma unroll 8
        for (int s = 0; s < 128; ++s) { const float a = AA[base + (size_t)s * D], bv = BB[base + (size_t)s * D]; Hh = a * Hh + bv; A *= a; }
        sA[tid] = A; sH[tid] = Hh;
        __syncthreads();
        if (tid < 32) { float carry = 0.f;
            for (int kk = 0; kk < 16; ++kk) { sC[kk * 32 + tid] = carry; carry = sA[kk * 32 + tid] * carry + sH[kk * 32 + tid]; } }
        __syncthreads();
        float h = sC[tid];
#pragma unroll 8
        for (int s = 0; s < 128; ++s) { const float a = AA[base + (size_t)s * D], bv = BB[base + (size_t)s * D]; h = a * h + bv;
            const float yg = __uint_as_float((unsigned)YG[base + (size_t)s * D] << 16);
            HY[base + (size_t)s * D] = (bf16)(cvtpk(yg * h, 0.f) & 0xffffu); }
        __syncthreads();
    }
}
__device__ __forceinline__ void fcum_phase(Frame& F, const float* logf, float* F2) {
    int wave_ = F.wave; asm volatile("" : "+s"(wave_)); const int wave = wave_, lane = pg8::fresh_lane(), tid = wave * 64 + lane; (void)tid;
    LAS float* sW = (LAS float*)(F.lds + RING_OFF);
    for (int bh = blockIdx.x; bh < NBATCH * NH; bh += F.G) {
        const int bb = bh >> 4, h = bh & 15, s0 = 4 * tid;
        float v[4];
#pragma unroll
        for (int i = 0; i < 4; ++i) v[i] = logf[((size_t)bb * SEQ + s0 + i) * NH + h];
        v[1] += v[0]; v[2] += v[1]; v[3] += v[2];
        float x = v[3];
#pragma unroll
        for (int o = 1; o < 64; o <<= 1) { const float t = __shfl_up(x, o); if (lane >= o) x += t; }
        if (lane == 63) sW[wave] = x;
        __syncthreads();
        float off = x - v[3];
        for (int w = 0; w < wave; ++w) off += sW[w];
        f32x4 o; o.x = (off + v[0]) * LOG2E; o.y = (off + v[1]) * LOG2E; o.z = (off + v[2]) * LOG2E; o.w = (off + v[3]) * LOG2E;
        *(GAS f32x4*)(F2 + (size_t)bh * SEQ + s0) = o;
        __syncthreads();
    }
}

__global__ void __launch_bounds__(NWAVES * 64, 2) mk_fwd(Args args) {
    extern __shared__ __attribute__((aligned(16))) unsigned char lds[];
    Frame F;
    F.lds = (LAS unsigned char*)lds;
    F.MISC = (volatile LAS unsigned*)(F.lds + MISC_OFF);
    F.wave = __builtin_amdgcn_readfirstlane(threadIdx.x >> 6);
    F.G = gridDim.x; { const int bx = blockIdx.x; F.vcu = (F.G % 8 == 0) ? (bx % 8) * (F.G / 8) + bx / 8 : bx; }
    for (int u = threadIdx.x; u < (LDS_BYTES - LDSCTL_OFF) / 4; u += NWAVES * 64) ((LAS unsigned*)(F.lds + LDSCTL_OFF))[u] = 0u;
    __syncthreads();
    if (threadIdx.x == 0) F.MISC[10] = (unsigned)F.G;
    __syncthreads();
    if (N_LAUNCHES == 1) (void)xcd_barrier_post((unsigned*)CTLP + CW_BAR, F.MISC + 8);
#define GRID_BAR(seam) do { if (N_LAUNCHES != 1) { if (threadIdx.x == 0) __hip_atomic_store(CTLP + CW_TMO, 0xBADBA0u | (unsigned)(seam), RLX_AGENT); } \
    else { XcdBarrier b_; b_.bar = (unsigned*)CTLP + CW_BAR; b_.x = xb_xcc_id(); b_.st = F.MISC + 8; b_.wave = (unsigned)F.wave; xcd_barrier(b_); } } while (0)
    const int lo = args.ph_lo, hi = args.ph_hi;
#define IN(k) (lo <= (k) && (k) < hi)
#define SEAM(k) do { if (IN((k) + 1)) GRID_BAR(k); } while (0)
#define ws WSP
#define XF ((float*)(WSP + WS_XF))
#define XB ((bf16*)(WSP + WS_XB))
#define PRE ((float*)(WSP + WS_PRE))
    const int G = F.G, cb = (int)blockIdx.x;

#define LRU_MIXER(P, J, RES) \
    if (IN(P)) { pg8::Gemm g{XB, (const bf16*)(ws + WS_WIN) + (size_t)(J) * 2 * D * D, D, D, D}; pg8::Order S; S.init(T / 256, 8, G, cb, 256u * D * 2, 0, 256u * D * 2, nullptr, 0); \
        pg8::EpiLruIn E{(bf16*)(ws + WS_YG), (float*)(ws + WS_REC)}; pg8::gemm_phase<pg8::EpiLruIn, pg8::Order, true, true>(F.lds + RING_OFF, g, S, E, F.wave); SEAM(P); } \
    if (IN((P) + 1)) { conv_phase(F, (const float*)(ws + WS_REC), INP(2) + (size_t)(J) * 4 * D, INP(3) + (size_t)(J) * D, (bf16*)(ws + WS_XR)); SEAM((P) + 1); } \
    if (IN((P) + 2)) { pg8::Gemm g{(const bf16*)(ws + WS_XR), (const bf16*)(ws + WS_WGATE) + (size_t)(J) * 8 * 256 * 128, D, 128, 128}; pg8::Order S; S.init(T / 256, 8, G, cb, 256u * D * 2, 128 * 2, 256u * 128 * 2, nullptr, 0); \
        pg8::EpiGates E{(const bf16*)(ws + WS_XR), INP(5) + (size_t)(J) * 8 * 256, INP(6) + (size_t)(J) * D, (float*)(ws + WS_AA), (float*)(ws + WS_BB)}; \
        pg8::gemm_phase<pg8::EpiGates, pg8::Order, true, true>(F.lds + RING_OFF, g, S, E, F.wave); SEAM((P) + 2); } \
    if (IN((P) + 3)) { scan_phase(F, (const float*)(ws + WS_AA), (const float*)(ws + WS_BB), (const bf16*)(ws + WS_YG), (bf16*)(ws + WS_HY)); SEAM((P) + 3); } \
    if (IN((P) + 4)) { pg8::Gemm g{(const bf16*)(ws + WS_HY), (const bf16*)(ws + WS_WOUT) + (size_t)(J) * D * D, D, D, D}; pg8::Order S; S.init(T / 256, 4, G, cb, 256u * D * 2, 0, 256u * D * 2, nullptr, 0); \
        pg8::EpiPre<true> E{RES, PRE, D, nullptr, ALPHA}; pg8::gemm_phase<pg8::EpiPre<true>, pg8::Order, true, true>(F.lds + RING_OFF, g, S, E, F.wave); SEAM((P) + 4); }
#define DENSE_FFN(P, I, L) \
    if (IN(P)) { pg8::Gemm g{XB, (const bf16*)(ws + WS_WGU) + (size_t)(I) * 2 * DFF * D, D, D, D}; pg8::Order S; S.init(T / 256, 2 * DFF / 256, G, cb, 256u * D * 2, 0, 256u * D * 2, nullptr, 0); \
        pg8::EpiSwiglu E{(bf16*)(ws + WS_HB), DFF}; pg8::gemm_phase<pg8::EpiSwiglu, pg8::Order, true, true>(F.lds + RING_OFF, g, S, E, F.wave); SEAM(P); } \
    if (IN((P) + 1)) { pg8::Gemm g{(const bf16*)(ws + WS_HB), (const bf16*)(ws + WS_WDN) + (size_t)(I) * D * DFF, DFF, DFF, DFF}; pg8::Order S; S.init(T / 256, 4, G, cb, 256u * DFF * 2, 0, 256u * DFF * 2, nullptr, 0); \
        pg8::EpiPre<true> E{XF, PRE, D, nullptr, ALPHA}; pg8::gemm_phase<pg8::EpiPre<true>, pg8::Order, true, true>(F.lds + RING_OFF, g, S, E, F.wave); SEAM((P) + 1); } \
    if (IN((P) + 2)) { ln_phase(F, PRE, INP(20) + (size_t)(L) * D, INP(21) + (size_t)(L) * D, XF, XB); SEAM((P) + 2); }
#define MOE_FFN(P, I, L, FG, XFO, XBO) \
    if (IN(P)) { ln_router_phase(F, PRE, INP(18) + (size_t)(L) * D, INP(19) + (size_t)(L) * D, XF, XB, INP(15) + (size_t)(I) * D * NE, CTLP + CW_CNT + (I) * 1024, (i32x4*)(ws + WS_TOK), (f32x2*)(ws + WS_GATE)); SEAM(P); } \
    if (IN((P) + 1)) { gather_phase(F, CTLP + CW_CNT + (I) * 1024, (const i32x4*)(ws + WS_TOK), XB, (bf16*)(ws + WS_ROWS), (i32x2*)(ws + WS_DEST), (int*)(ws + WS_BLKE) + (I) * 256); SEAM((P) + 1); } \
    if (IN((P) + 2)) { const int* blke = (const int*)(ws + WS_BLKE) + (I) * 256; const int nb = __builtin_amdgcn_readfirstlane(__hip_atomic_load(blke + 200, RLX_AGENT)); \
        pg8::Gemm g{(const bf16*)(ws + WS_ROWS), (const bf16*)(ws + WS_MGU) + (size_t)(I) * NE * 2 * DFF * D, D, D, D}; pg8::Order S; S.init(nb, 2 * DFF / 256, G, cb, 256u * D * 2, 0, 256u * D * 2, blke, 2u * DFF * D * 2); \
        pg8::EpiSwiglu E{(bf16*)(ws + WS_HB2), DFF}; pg8::gemm_phase<pg8::EpiSwiglu, pg8::Order, true, true>(F.lds + RING_OFF, g, S, E, F.wave); SEAM((P) + 2); } \
    if (IN((P) + 3)) { const int* blke = (const int*)(ws + WS_BLKE) + (I) * 256; const int nb = __builtin_amdgcn_readfirstlane(__hip_atomic_load(blke + 200, RLX_AGENT)); \
        pg8::Gemm g{(const bf16*)(ws + WS_HB2), (const bf16*)(ws + WS_MDN) + (size_t)(I) * NE * D * DFF, DFF, DFF, DFF}; pg8::Order S; S.init(nb, 4, G, cb, 256u * DFF * 2, 0, 256u * DFF * 2, blke, (unsigned)D * DFF * 2); \
        pg8::EpiPre<false> E{nullptr, (float*)(ws + WS_YROWS), D, nullptr, 1.f}; pg8::gemm_phase<pg8::EpiPre<false>, pg8::Order, true, true>(F.lds + RING_OFF, g, S, E, F.wave); SEAM((P) + 3); } \
    if (IN((P) + 4)) { combine_ln_phase<FG>(F, XF, (const float*)(ws + WS_YROWS), (const i32x2*)(ws + WS_DEST), (const f32x2*)(ws + WS_GATE), INP(20) + (size_t)(L) * D, INP(21) + (size_t)(L) * D, XFO, XBO, \
        INP(10), INP(11), (float*)(ws + WS_LOGF)); SEAM((P) + 4); }

    if (IN(0)) { p0_prologue(F); SEAM(0); }
    LRU_MIXER(1, 0, INP(0))
    if (IN(6)) { ln_phase(F, PRE, INP(18), INP(19), XF, XB); SEAM(6); }
    DENSE_FFN(7, 0, 0)
    if (IN(10)) { poolp_phase(F, XF, (bf16*)(ws + WS_PB)); SEAM(10); }
    if (IN(11)) { pg8::Gemm g{(const bf16*)(ws + WS_PB), (const bf16*)(ws + WS_WPOOL), D, 256, 256}; pg8::Order S; S.init(T / 256, 4, G, cb, 256u * D * 2, 256 * 2, 256u * 256 * 2, nullptr, 0);
        pg8::EpiPre<true> E{XF, PRE, D, INP(9), ALPHA}; pg8::gemm_phase<pg8::EpiPre<true>, pg8::Order, true, true>(F.lds + RING_OFF, g, S, E, F.wave); SEAM(11); }
    MOE_FFN(12, 0, 1, true, XF, XB)
    if (IN(17)) { fcum_phase(F, (const float*)(ws + WS_LOGF), (float*)(ws + WS_F2));
        pg8::Gemm g{XB, (const bf16*)(ws + WS_WQKV), D, D, D}; pg8::Order S; S.init(T / 256, 12, G, cb, 256u * D * 2, 0, 256u * D * 2, nullptr, 0);
        pg8::EpiBf16 E{(bf16*)(ws + WS_Q), D, D, (size_t)(WS_K - WS_Q) / 2, attn_body::C2};
        pg8::gemm_phase<pg8::EpiBf16, pg8::Order, true, true>(F.lds + RING_OFF, g, S, E, F.wave); SEAM(17); }
    if (IN(18)) { const attn_body::AttnTensors AT{(const attn_body::bf16*)(ws + WS_Q), (const attn_body::bf16*)(ws + WS_K), (const attn_body::bf16*)(ws + WS_V), (attn_body::bf16*)(ws + WS_Q), (const float*)(ws + WS_F2)};
        const attn_body::StaticOrder S((int)F.G, F.vcu);
        attn_body::attn_phase<attn_body::StaticOrder>((char*)lds + RING_OFF, AT, S, F.wave); SEAM(18); }
    if (IN(19)) { pg8::Gemm g{(const bf16*)(ws + WS_Q), (const bf16*)(ws + WS_WO), D, D, D}; pg8::Order S; S.init(T / 256, 4, G, cb, 256u * D * 2, 0, 256u * D * 2, nullptr, 0);
        pg8::EpiPre<true> E{XF, PRE, D, nullptr, ALPHA}; pg8::gemm_phase<pg8::EpiPre<true>, pg8::Order, true, true>(F.lds + RING_OFF, g, S, E, F.wave); SEAM(19); }
    if (IN(20)) { ln_phase(F, PRE, INP(18) + 2 * D, INP(19) + 2 * D, XF, XB); SEAM(20); }
    DENSE_FFN(21, 1, 2)
    LRU_MIXER(24, 1, XF)
    MOE_FFN(29, 1, 3, false, kargs()->out, (bf16*)nullptr)
#undef IN
#undef SEAM
#undef ws
#undef XF
#undef XB
#undef PRE
}

extern "C" void kernel_launch(void* const* d_in, const int* in_sizes, int n_in, void* d_out, int out_size, void* d_ws, size_t ws_size, hipStream_t stream) {
    static int grid = 0;
    if (grid == 0) {
        if (n_in != 22 || in_sizes[0] != T * D || out_size != T * D || ws_size < WS_END) { fprintf(stderr, "kernel_launch: unexpected shapes (n_in %d, in0 %d, out %d, ws %zu); nothing launched\n", n_in, n_in > 0 ? in_sizes[0] : -1, out_size, ws_size); grid = -1; return; }
        int dev = 0, cus = 0, per_cu = 0;
        if (hipGetDevice(&dev) != hipSuccess || hipDeviceGetAttribute(&cus, hipDeviceAttributeMultiprocessorCount, dev) != hipSuccess) { grid = -1; return; }
        if (hipFuncSetAttribute((const void*)mk_fwd, hipFuncAttributeMaxDynamicSharedMemorySize, LDS_BYTES) != hipSuccess) { fprintf(stderr, "kernel_launch: hipFuncSetAttribute failed\n"); grid = -1; return; }
        if (hipOccupancyMaxActiveBlocksPerMultiprocessor(&per_cu, (const void*)mk_fwd, NWAVES * 64, LDS_BYTES) != hipSuccess || per_cu < 1)
            fprintf(stderr, "kernel_launch: note: occupancy query reports %d workgroups per CU\n", per_cu);
        (void)hipGetLastError();
        grid = cus;
    }
    if (grid < 0) return;
    if (hipMemsetAsync((char*)d_ws + WS_CTL, 0, CTL_ZERO_BYTES, stream) != hipSuccess) { fprintf(stderr, "kernel_launch: hipMemsetAsync failed\n"); return; }
    Args a{};
    for (int i = 0; i < 22; ++i) a.in[i] = (const float*)d_in[i];
    a.out = (float*)d_out; a.wsbase = (unsigned char*)d_ws;
    for (int li = 0; li < N_LAUNCHES; ++li) {
        a.ph_lo = (N_LAUNCHES == 1) ? 0 : li; a.ph_hi = (N_LAUNCHES == 1) ? NPH : li + 1;
        hipLaunchKernelGGL(mk_fwd, dim3(grid), dim3(NWAVES * 64), LDS_BYTES, stream, a);
        const hipError_t le = hipPeekAtLastError();
        if (le != hipSuccess) { fprintf(stderr, "kernel_launch: launch %d failed: %s\n", li, hipGetErrorName(le)); break; }
    }
}
```

```cpp
#define MK_N_LAUNCHES 1
#include <hip/hip_runtime.h>
#include <hip/hip_bf16.h>
#include <cstdio>
#include <cstdint>
#include <cmath>
namespace pg8 {
#define PG8_LAS __attribute__((address_space(3)))
typedef unsigned short bf16_t;
typedef short bf16x8 __attribute__((ext_vector_type(8)));
typedef float f32x4 __attribute__((ext_vector_type(4)));
typedef unsigned u32x4 __attribute__((ext_vector_type(4)));
constexpr int BM = 256, BK = 64, HALF = 128, HTB = HALF * BK * 2  , STAGE_BYTES = 8 * HTB, NXCD = 8, WGM = 8;

__host__ __device__ __forceinline__ int lds_byte(int r, int c) { const int st = (r >> 4) * 2 + (c >> 5), rr = r & 15, cc = c & 31, ob = rr * 64 + cc * 2; return st * 1024 + (ob ^ (((ob >> 9) & 1) << 5)); }
__host__ __device__ __forceinline__ void stage_rc(int b, int& R, int& C) { const int st = b / 1024, sb = b % 1024, swz = sb ^ (((sb >> 9) & 1) << 5); R = (st >> 1) * 16 + swz / 64; C = (st & 1) * 32 + (swz % 64) / 2; }
__host__ __device__ __forceinline__ int perm32(int rho) { const int n = rho >> 4, i = rho & 15; return 8 * (i >> 2) + 4 * n + (i & 3); }

__device__ __forceinline__ int fresh_lane() { int l; asm volatile("v_mbcnt_lo_u32_b32 %0, -1, 0\n\tv_mbcnt_hi_u32_b32 %0, -1, %0" : "=v"(l)); return l; }
struct Unit { int pm, pn; size_t aoff, boff; };
struct Gemm { const bf16_t* A; const bf16_t* Bt; int lda, ldb, K; };

struct Order {
    int nM, nN, nwg, G, c; unsigned a_pm, a_pn, b_pn, b_e; const int* blk_e;
    __device__ __forceinline__ void init(int nM_, int nN_, int G_, int c_, unsigned a_pm_, unsigned a_pn_, unsigned b_pn_, const int* blk_e_, unsigned b_e_) {
        nM = nM_; nN = nN_; nwg = nM * nN; G = G_; c = c_; a_pm = a_pm_; a_pn = a_pn_; b_pn = b_pn_; blk_e = blk_e_; b_e = b_e_; }
    __device__ __forceinline__ bool next(int i, Unit& u) const {
        const long L = (long)i * G + c; if (L >= nwg) return false;
        int wgid = (int)L; { const int q = nwg / NXCD, r = nwg % NXCD, xcd = wgid % NXCD, off = wgid / NXCD; wgid = (xcd < r ? xcd * (q + 1) : r * (q + 1) + (xcd - r) * q) + off; }
        const int nig = WGM * nN, gid = wgid / nig, fm = gid * WGM, gsz = (nM - fm) < WGM ? (nM - fm) : WGM;
        u.pm = fm + ((wgid % nig) % gsz); u.pn = (wgid % nig) / gsz;
        u.aoff = (size_t)u.pm * a_pm + (size_t)u.pn * a_pn; u.boff = (size_t)u.pn * b_pn;
        if (blk_e) { const int e = __builtin_amdgcn_readfirstlane(__hip_atomic_load(blk_e + u.pm, __ATOMIC_RELAXED, __HIP_MEMORY_SCOPE_AGENT)); u.boff += (size_t)e * b_e; }
        return true;
    }
    __device__ __forceinline__ void a_ready(const Unit&) const {}
    __device__ __forceinline__ void done(const Unit&) const {}
};

__device__ __forceinline__ unsigned cvt_pk_bf16(float lo, float hi) { unsigned r; asm volatile("v_cvt_pk_bf16_f32 %0, %1, %2" : "=v"(r) : "v"(lo), "v"(hi)); return r; }
__device__ __forceinline__ float bf_lo(unsigned w) { return __uint_as_float(w << 16); }
__device__ __forceinline__ float bf_hi(unsigned w) { return __uint_as_float(w & 0xffff0000u); }
__device__ __forceinline__ float fast_sigmoid(float v) { return __builtin_amdgcn_rcpf(1.0f + __builtin_amdgcn_exp2f(-1.4426950408889634f * v)); }
__device__ __forceinline__ float gelu_tanh(float v) { const float t = v + 0.044715f * v * v * v; return v * __builtin_amdgcn_rcpf(1.0f + __builtin_amdgcn_exp2f(-2.302208198f * t)); }

__device__ __forceinline__ float one_minus_exp(float x) {
    float p = x * (1.0f / 5040.0f) + (1.0f / 720.0f); p = p * x + (1.0f / 120.0f); p = p * x + (1.0f / 24.0f); p = p * x + (1.0f / 6.0f); p = p * x + 0.5f; p = p * x + 1.0f;
    const float big = 1.0f - __builtin_amdgcn_exp2f(1.4426950408889634f * x);
    return x > -0.25f ? -(p * x) : big;
}
__device__ __forceinline__ float softplus_f(float y) {
    const float t = __builtin_amdgcn_exp2f(-1.4426950408889634f * __builtin_fabsf(y));
    float p = t * 0.2f - 0.25f; p = p * t + (1.0f / 3.0f); p = p * t - 0.5f; p = p * t + 1.0f;
    const float l1p = t < 0.0625f ? p * t : 0.6931471805599453f * __builtin_amdgcn_logf(1.0f + t);
    return __builtin_fmaxf(y, 0.f) + l1p;
}
struct EpiBf16 {
    static constexpr bool PERM = true, AFTER_DRAIN = false;
    bf16_t* O; int ldc; int split_cols; size_t split_stride; float scale0;
    __device__ __forceinline__ void operator()(const f32x4 (&acc)[2][2][4][2], const Unit& u, int wr, int wc, int fr, int fq) const {
        const int row0 = u.pm * BM + wr * 64 + fr; int colt = u.pn * BM; bf16_t* base = O;
        float sc = 1.f; { const int t = colt / split_cols; base += (size_t)t * split_stride; colt -= t * split_cols; if (t == 0) sc = scale0; }
        const int col0 = colt + wc * 32 + 8 * fq;
#pragma unroll
        for (int ai = 0; ai < 2; ++ai)
#pragma unroll
            for (int m = 0; m < 4; ++m) { bf16_t* rowp = base + (size_t)(row0 + ai * HALF + m * 16) * ldc + col0;
#pragma unroll
                for (int bj = 0; bj < 2; ++bj) { f32x4 v0 = acc[ai][bj][m][0] * sc, v1 = acc[ai][bj][m][1] * sc;
                    u32x4 w; w.x = cvt_pk_bf16(v0[0], v0[1]); w.y = cvt_pk_bf16(v0[2], v0[3]); w.z = cvt_pk_bf16(v1[0], v1[1]); w.w = cvt_pk_bf16(v1[2], v1[3]);
                    *(u32x4*)(rowp + bj * HALF) = w; } }
    }
};
struct EpiLruIn {
    static constexpr bool PERM = true, AFTER_DRAIN = false;
    bf16_t* YG; float* REC;
    __device__ __forceinline__ void operator()(const f32x4 (&acc)[2][2][4][2], const Unit& u, int wr, int wc, int fr, int fq) const {
        const int row0 = u.pm * BM + wr * 64 + fr;
        if (u.pn < 4) {
            const int col0 = u.pn * BM + wc * 32 + 8 * fq;
#pragma unroll
            for (int ai = 0; ai < 2; ++ai)
#pragma unroll
                for (int m = 0; m < 4; ++m) { bf16_t* rowp = YG + (size_t)(row0 + ai * HALF + m * 16) * 1024 + col0;
#pragma unroll
                    for (int bj = 0; bj < 2; ++bj) { const f32x4 v0 = acc[ai][bj][m][0], v1 = acc[ai][bj][m][1];
                        u32x4 w; w.x = cvt_pk_bf16(gelu_tanh(v0[0]), gelu_tanh(v0[1])); w.y = cvt_pk_bf16(gelu_tanh(v0[2]), gelu_tanh(v0[3]));
                        w.z = cvt_pk_bf16(gelu_tanh(v1[0]), gelu_tanh(v1[1])); w.w = cvt_pk_bf16(gelu_tanh(v1[2]), gelu_tanh(v1[3]));
                        *(u32x4*)(rowp + bj * HALF) = w; } }
        } else {
            const int col0 = (u.pn - 4) * BM + wc * 32 + 8 * fq;
#pragma unroll
            for (int ai = 0; ai < 2; ++ai)
#pragma unroll
                for (int m = 0; m < 4; ++m) { float* rowp = REC + (size_t)(row0 + ai * HALF + m * 16) * 1024 + col0;
#pragma unroll
                    for (int bj = 0; bj < 2; ++bj) { *(f32x4*)(rowp + bj * HALF) = acc[ai][bj][m][0]; *(f32x4*)(rowp + bj * HALF + 4) = acc[ai][bj][m][1]; } }
        }
    }
};
struct EpiGates {
    static constexpr bool PERM = true, AFTER_DRAIN = false;
    const bf16_t* XR; const float* bg; const float* lam; float* AA; float* BB;
    __device__ __forceinline__ void operator()(const f32x4 (&acc)[2][2][4][2], const Unit& u, int wr, int wc, int fr, int fq) const {
        const int row0 = u.pm * BM + wr * 64 + fr; const int cl = wc * 32 + 8 * fq, cg = u.pn * 128 + cl;
        float br[8], bi[8], sp[8];
#pragma unroll
        for (int q = 0; q < 8; ++q) { br[q] = bg[u.pn * 256 + cl + q]; bi[q] = bg[u.pn * 256 + 128 + cl + q]; sp[q] = 8.0f * softplus_f(-lam[cg + q]); }
#pragma unroll
        for (int ai = 0; ai < 2; ++ai)
#pragma unroll
            for (int m = 0; m < 4; ++m) { const size_t off = (size_t)(row0 + ai * HALF + m * 16) * 1024 + cg;
                const u32x4 xw = *(const u32x4*)(XR + off);
                float xr[8] = {bf_lo(xw.x), bf_hi(xw.x), bf_lo(xw.y), bf_hi(xw.y), bf_lo(xw.z), bf_hi(xw.z), bf_lo(xw.w), bf_hi(xw.w)};
                f32x4 av[2], bv[2];
#pragma unroll
                for (int n = 0; n < 2; ++n)
#pragma unroll
                    for (int j = 0; j < 4; ++j) { const int q = 4 * n + j;
                        const float r = fast_sigmoid(acc[ai][0][m][n][j] + br[q]), ig = fast_sigmoid(acc[ai][1][m][n][j] + bi[q]);
                        const float la = -sp[q] * r; const float a = __builtin_amdgcn_exp2f(1.4426950408889634f * la); const float mult = __builtin_amdgcn_sqrtf(one_minus_exp(2.0f * la));
                        av[n][j] = a; bv[n][j] = mult * (ig * xr[q]); }
                *(f32x4*)(AA + off) = av[0]; *(f32x4*)(AA + off + 4) = av[1]; *(f32x4*)(BB + off) = bv[0]; *(f32x4*)(BB + off + 4) = bv[1]; }
    }
};
template <bool RES> struct EpiPre {
    static constexpr bool PERM = false, AFTER_DRAIN = false;
    const float* res; float* out; int ldc; const float* scale; float alpha;
    __device__ __forceinline__ void operator()(const f32x4 (&acc)[2][2][4][2], const Unit& u, int wr, int wc, int fr, int fq) const {
        const int row0 = u.pm * BM + wr * 64 + fr, col0 = u.pn * BM + wc * 32 + 4 * fq;
        f32x4 sv[2][2];
#pragma unroll
        for (int bj = 0; bj < 2; ++bj)
#pragma unroll
            for (int n = 0; n < 2; ++n) sv[bj][n] = scale ? *(const f32x4*)(scale + col0 + bj * HALF + n * 16) : (f32x4){1.f, 1.f, 1.f, 1.f};
#pragma unroll
        for (int ai = 0; ai < 2; ++ai)
#pragma unroll
            for (int m = 0; m < 4; ++m) { const size_t off = (size_t)(row0 + ai * HALF + m * 16) * ldc + col0;
#pragma unroll
                for (int bj = 0; bj < 2; ++bj)
#pragma unroll
                    for (int n = 0; n < 2; ++n) { f32x4 o = acc[ai][bj][m][n] * sv[bj][n];
                        if (RES) { const f32x4 r = *(const f32x4*)(res + off + bj * HALF + n * 16); o = r * alpha + o; }
                        *(f32x4*)(out + off + bj * HALF + n * 16) = o; } }
    }
};
struct EpiSwiglu {
    static constexpr bool PERM = true, AFTER_DRAIN = false;
    bf16_t* O; int ldc;
    __device__ __forceinline__ void operator()(const f32x4 (&acc)[2][2][4][2], const Unit& u, int wr, int wc, int fr, int fq) const {
        const int row0 = u.pm * BM + wr * 64 + fr, col0 = u.pn * HALF + wc * 32 + 8 * fq;
#pragma unroll
        for (int ai = 0; ai < 2; ++ai)
#pragma unroll
            for (int m = 0; m < 4; ++m) { bf16_t* rowp = O + (size_t)(row0 + ai * HALF + m * 16) * ldc + col0;
                float h[8];
#pragma unroll
                for (int n = 0; n < 2; ++n)
#pragma unroll
                    for (int j = 0; j < 4; ++j) { const float g = acc[ai][0][m][n][j], up = acc[ai][1][m][n][j]; h[4 * n + j] = g * fast_sigmoid(g) * up; }
                u32x4 w; w.x = cvt_pk_bf16(h[0], h[1]); w.y = cvt_pk_bf16(h[2], h[3]); w.z = cvt_pk_bf16(h[4], h[5]); w.w = cvt_pk_bf16(h[6], h[7]);
                *(u32x4*)rowp = w; }
    }
};

template <class Epi, class Sched, bool ALIGN_EPI = false, bool SP2 = false>
__device__ __forceinline__ void gemm_phase(PG8_LAS unsigned char* lds, const Gemm g, const Sched& S, const Epi& E, const int wave_id  ) {
    int wid_ = wave_id; asm volatile("" : "+s"(wid_)); const int wid = wid_, lane = fresh_lane(), tid = wid * 64 + lane, wr = wid >> 2, wc = wid & 3, fr = lane & 15, fq = lane >> 4;
    const int K = g.K, nt = K / BK;
    unsigned voffA[2], voffB[2];
#pragma unroll
    for (int i = 0; i < 2; ++i) { int R, C; stage_rc(tid * 16 + i * 8192, R, C); const int Rb = Epi::PERM ? ((R & ~31) + perm32(R & 31)) : R;
        voffA[i] = (unsigned)(R * g.lda + C) * 2u; voffB[i] = (unsigned)(Rb * g.ldb + C) * 2u; }
    const size_t kstep = (size_t)(BK * 2);
    const size_t hstepA = (size_t)HALF * g.lda * 2, hstepB = (size_t)HALF * g.ldb * 2;
    const unsigned ldsw = (unsigned)wid * 1024u;
    const int aoff = lds_byte(wr * 64 + fr, fq * 8), boff = lds_byte(wc * 32 + fr, fq * 8);
#define PG8_SA(b, h) (((b) * 2 + (h)) * HTB)
#define PG8_SB(b, h) ((4 + (b) * 2 + (h)) * HTB)
#define PG8_STAGE(bufoff, gbase, voff) do { _Pragma("unroll") for (int _i = 0; _i < 2; ++_i) \
        __builtin_amdgcn_global_load_lds((const unsigned*)((const char*)(gbase) + (voff)[_i]), (PG8_LAS unsigned*)(lds + (bufoff) + ldsw + _i * 8192), 16, 0, 0); } while (0)
#define PG8_LDA(dst, b, h) do { _Pragma("unroll") for (int m = 0; m < 4; ++m) _Pragma("unroll") for (int k = 0; k < 2; ++k) dst[m][k] = *(const PG8_LAS bf16x8*)(lds + PG8_SA(b, h) + aoff + m * 2048 + k * 1024); } while (0)
#define PG8_LDB(dst, b, h) do { _Pragma("unroll") for (int n = 0; n < 2; ++n) _Pragma("unroll") for (int k = 0; k < 2; ++k) dst[n][k] = *(const PG8_LAS bf16x8*)(lds + PG8_SB(b, h) + boff + n * 2048 + k * 1024); } while (0)
#define PG8_MMA(ai, bj, At, Bt) do { __builtin_amdgcn_s_setprio(1); _Pragma("unroll") for (int m = 0; m < 4; ++m) _Pragma("unroll") for (int n = 0; n < 2; ++n) _Pragma("unroll") for (int k = 0; k < 2; ++k) \
        acc[ai][bj][m][n] = __builtin_amdgcn_mfma_f32_16x16x32_bf16(Bt[n][k], At[m][k], acc[ai][bj][m][n], 0, 0, 0); __builtin_amdgcn_s_setprio(0); } while (0)
#define PG8_WAIT_V(n) asm volatile("s_waitcnt vmcnt(" #n ")" ::: "memory")
#define PG8_WAIT_L(n) asm volatile("s_waitcnt lgkmcnt(" #n ")" ::: "memory")
#define PG8_BAR __builtin_amdgcn_s_barrier()
#define PG8_SCHED __builtin_amdgcn_sched_barrier(0)
    Unit cur, nxt; int ui = 0;
    if (!S.next(0, cur)) return;
    f32x4 acc[2][2][4][2];
#pragma unroll
    for (int a = 0; a < 2; ++a)
#pragma unroll
        for (int b = 0; b < 2; ++b)
#pragma unroll
            for (int m = 0; m < 4; ++m)
#pragma unroll
                for (int n = 0; n < 2; ++n) acc[a][b][m][n] = (f32x4){0.f, 0.f, 0.f, 0.f};
    bf16x8 At[4][2], B0[2][2], B1[2][2];
    const char* cA = (const char*)g.A + cur.aoff; const char* cB = (const char*)g.Bt + cur.boff;
    S.a_ready(cur);
    if constexpr (SP2) {
        PG8_STAGE(PG8_SB(0, 0), cB, voffB); PG8_STAGE(PG8_SB(0, 1), cB + hstepB, voffB); PG8_STAGE(PG8_SA(0, 0), cA, voffA); PG8_STAGE(PG8_SA(0, 1), cA + hstepA, voffA);
        if (wr == 1) PG8_BAR;
        PG8_WAIT_V(2); PG8_BAR;
        PG8_STAGE(PG8_SB(1, 0), cB + kstep, voffB); PG8_STAGE(PG8_SA(1, 0), cA + kstep, voffA); PG8_STAGE(PG8_SB(1, 1), cB + hstepB + kstep, voffB);
        PG8_WAIT_V(6); PG8_BAR;
    } else {
        PG8_STAGE(PG8_SB(0, 0), cB, voffB); PG8_STAGE(PG8_SA(0, 0), cA, voffA); PG8_STAGE(PG8_SB(0, 1), cB + hstepB, voffB); PG8_STAGE(PG8_SA(0, 1), cA + hstepA, voffA);
        if (wr == 1) PG8_BAR;
        PG8_WAIT_V(4); PG8_BAR;
        PG8_STAGE(PG8_SB(1, 0), cB + kstep, voffB); PG8_STAGE(PG8_SA(1, 0), cA + kstep, voffA); PG8_STAGE(PG8_SB(1, 1), cB + hstepB + kstep, voffB);
        PG8_WAIT_V(6); PG8_BAR;
    }
    for (;;) {
        const bool has_next = S.next(ui + 1, nxt);
        const char* nA = has_next ? (const char*)g.A + nxt.aoff : cA; const char* nB = has_next ? (const char*)g.Bt + nxt.boff : cB;
        for (int t = 0; t < nt; t += 2) {
            const bool last = (t == nt - 2);
            const char* a1 = cA + (size_t)(t + 1) * kstep;
            const char* a2 = last ? nA : cA + (size_t)(t + 2) * kstep; const char* b2 = last ? nB : cB + (size_t)(t + 2) * kstep;
            const char* a3 = a2 + kstep; const char* b3 = b2 + kstep;
            if (last && has_next) S.a_ready(nxt);
            if constexpr (SP2) {
            PG8_LDB(B0, 0, 0); PG8_LDB(B1, 0, 1); PG8_SCHED; PG8_LDA(At, 0, 0); PG8_STAGE(PG8_SA(1, 1), a1 + hstepA, voffA);
            PG8_WAIT_V(8); PG8_WAIT_L(0); PG8_BAR; PG8_MMA(0, 0, At, B0); PG8_MMA(0, 1, At, B1); PG8_BAR; PG8_SCHED;
            PG8_LDA(At, 0, 1); PG8_STAGE(PG8_SB(0, 0), b2, voffB); PG8_STAGE(PG8_SB(0, 1), b2 + hstepB, voffB); PG8_STAGE(PG8_SA(0, 0), a2, voffA);
            PG8_WAIT_V(8); PG8_WAIT_L(0); PG8_BAR; PG8_MMA(1, 0, At, B0); PG8_MMA(1, 1, At, B1); PG8_BAR; PG8_SCHED;
            PG8_LDB(B0, 1, 0); PG8_LDB(B1, 1, 1); PG8_SCHED; PG8_LDA(At, 1, 0); PG8_STAGE(PG8_SA(0, 1), a2 + hstepA, voffA);
            PG8_WAIT_V(8); PG8_WAIT_L(0); PG8_BAR; PG8_MMA(0, 0, At, B0); PG8_MMA(0, 1, At, B1); PG8_BAR; PG8_SCHED;
            PG8_LDA(At, 1, 1); PG8_STAGE(PG8_SB(1, 0), b3, voffB); PG8_STAGE(PG8_SB(1, 1), b3 + hstepB, voffB); PG8_STAGE(PG8_SA(1, 0), a3, voffA);
            PG8_WAIT_V(8); PG8_WAIT_L(0); PG8_BAR; PG8_MMA(1, 0, At, B0); PG8_MMA(1, 1, At, B1); PG8_BAR; PG8_SCHED;
            } else {
            PG8_LDB(B0, 0, 0); PG8_SCHED; PG8_LDA(At, 0, 0); PG8_STAGE(PG8_SA(1, 1), a1 + hstepA, voffA);
            PG8_WAIT_L(8); PG8_BAR; PG8_WAIT_L(0); PG8_MMA(0, 0, At, B0); PG8_BAR; PG8_SCHED;
            PG8_LDB(B1, 0, 1); PG8_STAGE(PG8_SB(0, 0), b2, voffB);
            PG8_BAR; PG8_WAIT_L(0); PG8_MMA(0, 1, At, B1); PG8_BAR;
            PG8_LDA(At, 0, 1); PG8_STAGE(PG8_SA(0, 0), a2, voffA);
            PG8_BAR; PG8_WAIT_L(0); PG8_MMA(1, 0, At, B0); PG8_BAR; PG8_SCHED;
            PG8_STAGE(PG8_SB(0, 1), b2 + hstepB, voffB);
            PG8_WAIT_V(6); PG8_BAR; PG8_MMA(1, 1, At, B1); PG8_BAR;
            PG8_LDB(B0, 1, 0); PG8_SCHED; PG8_LDA(At, 1, 0); PG8_STAGE(PG8_SA(0, 1), a2 + hstepA, voffA);
            PG8_WAIT_L(8); PG8_BAR; PG8_WAIT_L(0); PG8_MMA(0, 0, At, B0); PG8_BAR; PG8_SCHED;
            PG8_LDB(B1, 1, 1); PG8_STAGE(PG8_SB(1, 0), b3, voffB);
            PG8_BAR; PG8_WAIT_L(0); PG8_MMA(0, 1, At, B1); PG8_BAR;
            PG8_LDA(At, 1, 1); PG8_STAGE(PG8_SA(1, 0), a3, voffA);
            PG8_BAR; PG8_WAIT_L(0); PG8_MMA(1, 0, At, B0); PG8_BAR; PG8_SCHED;
            PG8_STAGE(PG8_SB(1, 1), b3 + hstepB, voffB);
            PG8_WAIT_V(6); PG8_BAR; PG8_MMA(1, 1, At, B1); PG8_BAR;
            }
        }
        if constexpr (ALIGN_EPI) { if (wr == 0) PG8_BAR; }
        if constexpr (!Epi::AFTER_DRAIN) { const int le = fresh_lane(); E(acc, cur, wr, wc, le & 15, le >> 4); S.done(cur); }
        if (!has_next) break;
#pragma unroll
        for (int a = 0; a < 2; ++a)
#pragma unroll
            for (int b = 0; b < 2; ++b)
#pragma unroll
                for (int m = 0; m < 4; ++m)
#pragma unroll
                    for (int n = 0; n < 2; ++n) acc[a][b][m][n] = (f32x4){0.f, 0.f, 0.f, 0.f};
        cur = nxt; cA = nA; cB = nB; ++ui;
        if constexpr (ALIGN_EPI) { if (wr == 1) PG8_BAR; }
    }
    PG8_WAIT_V(0);
    if constexpr (!ALIGN_EPI) { if (wr == 0) PG8_BAR; }
    PG8_BAR;
    if constexpr (Epi::AFTER_DRAIN) { E.fused(acc, cur, wr, wc, fr, fq, lds, wid, lane); S.done(cur); }
#undef PG8_SA
#undef PG8_SB
#undef PG8_STAGE
#undef PG8_LDA
#undef PG8_LDB
#undef PG8_MMA
#undef PG8_WAIT_V
#undef PG8_WAIT_L
#undef PG8_BAR
#undef PG8_SCHED
}
}
#include <hip/hip_bf16.h>
#include <cmath>
namespace attn_body {
using bf16=__hip_bfloat16;
using bf16x8=__attribute__((ext_vector_type(8)))short;
using s16x4=__attribute__((ext_vector_type(4)))short;
using f32x16=__attribute__((ext_vector_type(16)))float;
using u32x4=__attribute__((ext_vector_type(4)))unsigned;
using f32x4=__attribute__((ext_vector_type(4)))float;
constexpr int BATCH=8,NHEAD=16,SEQ=2048,D=64,DM=NHEAD*D;
constexpr int NW=8,QBLK=32,QB=QBLK*NW,KVBLK=64,NQB=SEQ/QB;
constexpr int ATTN_PITCH=DM, ATTN_UNIT_ROWS=QB;
__device__ __forceinline__ int crow(int r,int hi){return (r&3)+8*(r>>2)+4*hi;}
#define SBAR() __builtin_amdgcn_sched_barrier(0)
__device__ __forceinline__ void cmask(f32x16&p0,f32x16&p1,int jb,int qrel,int hi){
  const float NEG=-INFINITY; int kb=64*jb+4*hi;
  #pragma unroll
  for(int r=0;r<16;++r){int kv=kb+(r&3)+8*(r>>2); if(kv>qrel)p0[r]=NEG; if(kv+32>qrel)p1[r]=NEG;}
}

constexpr int NSLOT=3, SLOTB=8192;
constexpr int LDS_K=0, LDS_V=NSLOT*SLOTB, LDS_WS=2*NSLOT*SLOTB, LDS_OST=LDS_WS+NW*64*4, LDS_F=LDS_OST+NW*4096, LDS_BYTES=LDS_F+SEQ*4;
constexpr float C2=0.125f*1.4426950408889634f;
__device__ __forceinline__ void glds16(const void*gsrc,unsigned lds_dst){unsigned keep;
  asm volatile("s_mov_b32 %0, m0\n\ts_mov_b32 m0, %2\n\ts_nop 0\n\tglobal_load_lds_dwordx4 %1, off\n\ts_mov_b32 m0, %0":"=&s"(keep):"v"(gsrc),"s"(lds_dst):"memory");}
__device__ __forceinline__ float max3f(float a,float b,float c){float r;asm("v_max3_f32 %0, %1, %2, %3":"=v"(r):"v"(a),"v"(b),"v"(c));return r;}
__device__ __forceinline__ float max2f(float a,float b){float r;asm("v_max_f32_e32 %0, %1, %2":"=v"(r):"v"(a),"v"(b));return r;}
__device__ __forceinline__ float fadd_s(float a,float b){float r;asm("v_add_f32_e32 %0, %1, %2":"=v"(r):"v"(a),"v"(b));return r;}
__device__ __forceinline__ float fsub_s(float a,float b){float r;asm("v_sub_f32_e32 %0, %1, %2":"=v"(r):"v"(a),"v"(b));return r;}
typedef float f32x2_t __attribute__((ext_vector_type(2))); typedef __bf16 bf16x2_t __attribute__((ext_vector_type(2)));
__device__ __forceinline__ unsigned cvtpk_s(float lo,float hi){f32x2_t v={lo,hi};bf16x2_t b=__builtin_convertvector(v,bf16x2_t);return __builtin_bit_cast(unsigned,b);}
#define WAIT_BAR(N) asm volatile("s_waitcnt vmcnt(" #N ") lgkmcnt(0)\n\ts_barrier":::"memory")

__device__ __forceinline__ void qkt(f32x16&p0,f32x16&p1,const char*Kslot,const bf16x8*qr,const f32x16&negm,int r32,int hi){
  const char*kb=Kslot+hi*1024+r32*16;
  #pragma unroll
  for(int d0=0;d0<4;++d0){
    const bf16x8 b0=*reinterpret_cast<const bf16x8*>(kb+d0*2048);
    const bf16x8 b1=*reinterpret_cast<const bf16x8*>(kb+d0*2048+512);
    if(d0==0){p0=__builtin_amdgcn_mfma_f32_32x32x16_bf16(b0,qr[0],negm,0,0,0);p1=__builtin_amdgcn_mfma_f32_32x32x16_bf16(b1,qr[0],negm,0,0,0);}
    else{p0=__builtin_amdgcn_mfma_f32_32x32x16_bf16(b0,qr[d0],p0,0,0,0);p1=__builtin_amdgcn_mfma_f32_32x32x16_bf16(b1,qr[d0],p1,0,0,0);}}
}
typedef __attribute__((address_space(3))) const char* lds_cptr;
typedef short v4i16_t __attribute__((ext_vector_type(4)));
__device__ __forceinline__ void kload8(bf16x8*kf,lds_cptr kp){
  kf[0]=*(const __attribute__((address_space(3))) bf16x8*)(kp);      kf[1]=*(const __attribute__((address_space(3))) bf16x8*)(kp+512);
  kf[2]=*(const __attribute__((address_space(3))) bf16x8*)(kp+2048); kf[3]=*(const __attribute__((address_space(3))) bf16x8*)(kp+2560);
  kf[4]=*(const __attribute__((address_space(3))) bf16x8*)(kp+4096); kf[5]=*(const __attribute__((address_space(3))) bf16x8*)(kp+4608);
  kf[6]=*(const __attribute__((address_space(3))) bf16x8*)(kp+6144); kf[7]=*(const __attribute__((address_space(3))) bf16x8*)(kp+6656);
}
__device__ __forceinline__ void kload2(bf16x8*kf,lds_cptr kp,int j){ kf[2*j]=*(const __attribute__((address_space(3))) bf16x8*)(kp+j*2048); kf[2*j+1]=*(const __attribute__((address_space(3))) bf16x8*)(kp+j*2048+512); }
__device__ __forceinline__ s16x4 vtr(lds_cptr p){ return __builtin_bit_cast(s16x4,__builtin_amdgcn_ds_read_tr16_b64_v4i16((__attribute__((address_space(3))) v4i16_t*)p)); }
__device__ __forceinline__ float rowmax(const f32x16&p0,const f32x16&p1){
  float a=max3f(p0[0],p0[1],p1[0]),b=max3f(p0[2],p0[3],p1[1]);a=max3f(a,p1[2],p1[3]);
  #pragma unroll
  for(int r=4;r<16;r+=4){a=max3f(a,p0[r],p0[r+1]);b=max3f(b,p0[r+2],p0[r+3]);a=max3f(a,p1[r],p1[r+1]);b=max3f(b,p1[r+2],p1[r+3]);}
  const float m=max2f(a,b);
  auto rr=__builtin_amdgcn_permlane32_swap(__float_as_uint(m),__float_as_uint(m),false,false);
  return max2f(__uint_as_float(rr[0]),__uint_as_float(rr[1]));
}
__device__ __forceinline__ void pv(f32x16*o,int vb,bf16x8 pa0,bf16x8 pa1,bf16x8 pa2,bf16x8 pa3){
  #pragma unroll
  for(int d0=0;d0<2;++d0){s16x4 lo[4],hi[4];
    #pragma unroll
    for(int ks=0;ks<4;++ks){
      asm volatile("ds_read_b64_tr_b16 %0,%1 offset:%c2":"=&v"(lo[ks]):"v"(vb),"i"(d0*4096+ks*1024):"memory");
      asm volatile("ds_read_b64_tr_b16 %0,%1 offset:%c2":"=&v"(hi[ks]):"v"(vb),"i"(d0*4096+ks*1024+512):"memory");}
    asm volatile("s_waitcnt lgkmcnt(0)":::"memory");SBAR();
    #define PK(k) (bf16x8){lo[k][0],lo[k][1],lo[k][2],lo[k][3],hi[k][0],hi[k][1],hi[k][2],hi[k][3]}
    o[d0]=__builtin_amdgcn_mfma_f32_32x32x16_bf16(pa0,PK(0),o[d0],0,0,0);
    o[d0]=__builtin_amdgcn_mfma_f32_32x32x16_bf16(pa1,PK(1),o[d0],0,0,0);
    o[d0]=__builtin_amdgcn_mfma_f32_32x32x16_bf16(pa2,PK(2),o[d0],0,0,0);
    o[d0]=__builtin_amdgcn_mfma_f32_32x32x16_bf16(pa3,PK(3),o[d0],0,0,0);
    #undef PK
  }
}

#ifndef ATTN_STORE16
#define ATTN_STORE16(p,v) (*(u32x4*)(p)=(v))
#endif
template<int THRL> __device__ __forceinline__ void attn_unit(int b,int h,int qb,const bf16*Q,const bf16*__restrict__ K,const bf16*__restrict__ V,bf16*O,const float*__restrict__ F2,char*shm,const int wave_id){
  int lane_; asm volatile("v_mbcnt_lo_u32_b32 %0, -1, 0\n\tv_mbcnt_hi_u32_b32 %0, -1, %0":"=v"(lane_)); int wid_=wave_id; asm volatile("":"+s"(wid_)); const int wid=wid_,lane=lane_,tid=wid*64+lane,r32=lane&31,hi=lane>>5;
  const long rowbase=(long)b*SEQ; const int q0=qb*QB;
  const bf16*Qw=Q+(rowbase+q0+wid*QBLK)*DM+h*D;
  const bf16*Kh=K+rowbase*DM+h*D,*Vh=V+rowbase*DM+h*D;
  const unsigned lds0=(unsigned)(uintptr_t)shm;
  float*wsf=(float*)(shm+LDS_WS)+wid*64;
  const bf16*ksrc=Kh+(long)lane*DM+wid*8;
  const bf16*vsrc=Vh+(long)(16*(wid&3)+(lane>>2))*DM+(wid>>2)*32+(lane&3)*8;
  const unsigned kdst=lds0+LDS_K+wid*1024, vdst=lds0+LDS_V+wid*1024;
  #define DMA_K(t,slot) glds16(ksrc+(long)(t)*KVBLK*DM,(unsigned)__builtin_amdgcn_readfirstlane(kdst+(slot)))
  #define DMA_V(t,slot) glds16(vsrc+(long)(t)*KVBLK*DM,(unsigned)__builtin_amdgcn_readfirstlane(vdst+(slot)))
  const int vb0=(int)(lds0+LDS_V)+((lane>>4)&1)*32+(lane&3)*8+(4*hi+((lane&15)>>2))*64;
  const char*Kbase=shm+LDS_K; bf16x8 kf[8];
  const lds_cptr shm3=(lds_cptr)shm; const lds_cptr kp0=shm3+LDS_K+hi*1024+r32*16; const lds_cptr vp0=shm3+LDS_V+((lane>>4)&1)*32+(lane&3)*8+(4*hi+((lane&15)>>2))*64;
  const int NT=(q0+QB)/KVBLK;
  __attribute__((address_space(3))) float*const fl=(__attribute__((address_space(3))) float*)shm+LDS_F/4;
  { const int nf4=(q0+QB)/4; for(int i=tid;i<nf4;i+=NW*64){ const f32x4 v=*reinterpret_cast<const f32x4*>(F2+4*i); *reinterpret_cast<__attribute__((address_space(3))) f32x4*>(fl+4*i)=v; } }
  DMA_K(0,0);DMA_V(0,0);DMA_K(1,SLOTB);
  bf16x8 qr[4];
  #pragma unroll
  for(int d0=0;d0<4;++d0)qr[d0]=*reinterpret_cast<const bf16x8*>(&Qw[(long)r32*DM+d0*16+hi*8]);
  float mhat=0.f,l_reg=0.f;f32x16 o[2];o[0]=f32x16{};o[1]=f32x16{};f32x16 negm=f32x16{};asm volatile("":"+v"(negm));
  const int qrel=wid*QBLK+r32;
  #define FBIAS(P0,P1,t) do{ const __attribute__((address_space(3))) f32x4*fp_=(const __attribute__((address_space(3))) f32x4*)fl+16*(t)+hi; \
    _Pragma("unroll") for(int g_=0;g_<4;++g_){ const f32x4 fa_=fp_[2*g_],fb_=fp_[8+2*g_]; \
      P0[4*g_]-=fa_[0];P0[4*g_+1]-=fa_[1];P0[4*g_+2]-=fa_[2];P0[4*g_+3]-=fa_[3];P1[4*g_]-=fb_[0];P1[4*g_+1]-=fb_[1];P1[4*g_+2]-=fb_[2];P1[4*g_+3]-=fb_[3]; } }while(0)
  #define CMASK(P0,P1,t) do{int jb_=(t)-(NT-4); if(jb_>=0)cmask(P0,P1,jb_,qrel,hi);}while(0)
  bool resc=false;
  #define START(P0,P1) do{ const float rm=rowmax(P0,P1); resc=false; \
    { const float dl=rm; mhat=fadd_s(mhat,dl); \
      _Pragma("unroll") for(int r=0;r<16;++r){P0[r]=fsub_s(P0[r],dl);P1[r]=fsub_s(P1[r],dl);} \
      _Pragma("unroll") for(int r=0;r<16;++r)negm[r]=-mhat; asm volatile("":"+v"(negm)); } \
    _Pragma("unroll") for(int r=0;r<16;++r)P0[r]=__builtin_amdgcn_exp2f(P0[r]); }while(0)
  #define RESC() do{ if(resc){ asm volatile("s_waitcnt lgkmcnt(0)":::"memory"); \
      _Pragma("unroll") for(int d_=0;d_<2;++d_) _Pragma("unroll") for(int r=0;r<16;++r)o[d_][r]*=wsf[crow(r,hi)]; } }while(0)
  f32x16 pA0,pA1,pB0,pB1;
  int sl_prev=0,sl_cur=0,sl_next=SLOTB;
  #define ROT() do{sl_prev=sl_cur;sl_cur=sl_next;sl_next=(sl_next==(NSLOT-1)*SLOTB)?0:sl_next+SLOTB;}while(0)
  DMA_K(2,2*SLOTB);
  WAIT_BAR(3);
  { const float Fq=fl[q0+qrel]; mhat=-Fq; _Pragma("unroll") for(int r=0;r<16;++r)negm[r]=Fq; asm volatile("":"+v"(negm)); }
  qkt(pA0,pA1,Kbase,qr,negm,r32,hi);asm volatile("s_nop 15\n\ts_nop 7":"+v"(pA0),"+v"(pA1));FBIAS(pA0,pA1,0);CMASK(pA0,pA1,0);
  START(pA0,pA1);
  _Pragma("unroll") for(int r=0;r<16;++r)pA1[r]=__builtin_amdgcn_exp2f(pA1[r]);
  WAIT_BAR(0);
  DMA_K(3,0);DMA_V(1,SLOTB);
  ROT();
  kload8(kf,kp0+sl_cur);
  WAIT_BAR(2);
  s16x4 vlo[8],vhi[8]; u32x4 pw0,pw1,pw2,pw3;
  #define PKW(P,B) cvtpk_s(P[B],P[B+1])
  #define PAF(k) __builtin_bit_cast(bf16x8,pw##k)
  #define VFR(i) (bf16x8){vlo[i][0],vlo[i][1],vlo[i][2],vlo[i][3],vhi[i][0],vhi[i][1],vhi[i][2],vhi[i][3]}
  #define PIN(x) asm volatile("":"+v"(x))
  #define MX3(a,b,c) __builtin_fmaxf(__builtin_fmaxf((a),(b)),(c))
  #define GAPA(MF,A0,A1,A2,A3,W0,W1,PW) do{ MF; sacc+=A0; sacc+=A1; sacc+=A2; sacc+=A3; PIN(sacc); W0; W1; PIN(PW); SBAR(); }while(0)
  #define EX(v) __builtin_amdgcn_exp2f(v)
  #define GAPB(MF,X,B) do{ MF; X[B]=EX(X[B]); X[B+1]=EX(X[B+1]); X[B+2]=EX(X[B+2]); X[B+3]=EX(X[B+3]); PIN(X); SBAR(); }while(0)
  #define VRD(i) do{ vlo[i]=vtr(vp_+(((i)>>2)*4096+((i)&3)*1024)); vhi[i]=vtr(vp_+(((i)>>2)*4096+((i)&3)*1024+512)); }while(0)
  #define KRD(G,j) do{ if(G){ kload2(kf,kp0+sl_next,j); SBAR(); } }while(0)
  #define STEP(C0,C1,P0,P1,t,GK,GV,GL) do{ SBAR(); \
    const lds_cptr vp_=vp0+sl_prev; \
    VRD(0); SBAR(); float sacc=(P0[0]+P0[1]); \
    GAPA(C0=__builtin_amdgcn_mfma_f32_32x32x16_bf16(kf[0],qr[0],negm,0,0,0), P0[2],P0[3],P0[4],P0[5],     pw0[0]=PKW(P0,0), pw0[1]=PKW(P0,2), pw0); \
    VRD(4); SBAR(); GAPA(C1=__builtin_amdgcn_mfma_f32_32x32x16_bf16(kf[1],qr[0],negm,0,0,0), P0[6],P0[7],P0[8],P0[9],     pw0[2]=PKW(P0,4), pw0[3]=PKW(P0,6), pw0); \
    VRD(1); SBAR(); GAPA(C0=__builtin_amdgcn_mfma_f32_32x32x16_bf16(kf[2],qr[1],C0,0,0,0),   P0[10],P0[11],P0[12],P0[13], pw1[0]=PKW(P0,8), pw1[1]=PKW(P0,10), pw1); \
    VRD(5); SBAR(); GAPA(C1=__builtin_amdgcn_mfma_f32_32x32x16_bf16(kf[3],qr[1],C1,0,0,0),   P0[14],P0[15],P1[0],P1[1],   pw1[2]=PKW(P0,12),pw1[3]=PKW(P0,14), pw1); \
    VRD(2); SBAR(); GAPA(C0=__builtin_amdgcn_mfma_f32_32x32x16_bf16(kf[4],qr[2],C0,0,0,0),   P1[2],P1[3],P1[4],P1[5],     pw2[0]=PKW(P1,0), pw2[1]=PKW(P1,2), pw2); \
    VRD(6); SBAR(); GAPA(C1=__builtin_amdgcn_mfma_f32_32x32x16_bf16(kf[5],qr[2],C1,0,0,0),   P1[6],P1[7],P1[8],P1[9],     pw2[2]=PKW(P1,4), pw2[3]=PKW(P1,6), pw2); \
    VRD(3); SBAR(); GAPA(C0=__builtin_amdgcn_mfma_f32_32x32x16_bf16(kf[6],qr[3],C0,0,0,0),   P1[10],P1[11],P1[12],P1[13], pw3[0]=PKW(P1,8), pw3[1]=PKW(P1,10), pw3); \
    VRD(7); SBAR(); GAPA(C1=__builtin_amdgcn_mfma_f32_32x32x16_bf16(kf[7],qr[3],C1,0,0,0),   P1[14],P1[15],0.f,0.f,       pw3[2]=PKW(P1,12),pw3[3]=PKW(P1,14), pw3); \
    l_reg+=sacc; \
    if(GK){DMA_K((t)+3,sl_cur);} if(GV){DMA_V((t)+1,sl_next);} \
    FBIAS(C0,C1,t); CMASK(C0,C1,t); \
    { float a=MX3(C0[0],C0[1],C1[0]),b=MX3(C0[2],C0[3],C1[1]); a=MX3(a,C1[2],C1[3]); \
      _Pragma("unroll") for(int r=4;r<16;r+=4){a=MX3(a,C0[r],C0[r+1]);b=MX3(b,C0[r+2],C0[r+3]);a=MX3(a,C1[r],C1[r+1]);b=MX3(b,C1[r+2],C1[r+3]);} \
      float rm=__builtin_fmaxf(a,b); { auto rr=__builtin_amdgcn_permlane32_swap(__float_as_uint(rm),__float_as_uint(rm),false,false); rm=__builtin_fmaxf(__uint_as_float(rr[0]),__uint_as_float(rr[1])); } \
      resc=false; \
      if(__builtin_expect(__any(rm>(float)THRL),0)){ const float dl=__builtin_fmaxf(rm,0.f); mhat+=dl; \
        _Pragma("unroll") for(int r=0;r<16;++r){C0[r]-=dl;C1[r]-=dl;} \
        _Pragma("unroll") for(int r=0;r<16;++r)negm[r]=-mhat; asm volatile("":"+v"(negm)); \
        const float f=__builtin_amdgcn_exp2f(-dl); l_reg*=f; if(hi==0)wsf[r32]=f; resc=true; } } \
    SBAR(); \
    GAPB(o[0]=__builtin_amdgcn_mfma_f32_32x32x16_bf16(PAF(0),VFR(0),o[0],0,0,0), C0,0); \
    GAPB(o[1]=__builtin_amdgcn_mfma_f32_32x32x16_bf16(PAF(0),VFR(4),o[1],0,0,0), C0,4); \
    KRD(GL,0); GAPB(o[0]=__builtin_amdgcn_mfma_f32_32x32x16_bf16(PAF(1),VFR(1),o[0],0,0,0), C0,8); \
    KRD(GL,1); GAPB(o[1]=__builtin_amdgcn_mfma_f32_32x32x16_bf16(PAF(1),VFR(5),o[1],0,0,0), C0,12); \
    KRD(GL,2); GAPB(o[0]=__builtin_amdgcn_mfma_f32_32x32x16_bf16(PAF(2),VFR(2),o[0],0,0,0), C1,0); \
    KRD(GL,3); GAPB(o[1]=__builtin_amdgcn_mfma_f32_32x32x16_bf16(PAF(2),VFR(6),o[1],0,0,0), C1,4); \
    GAPB(o[0]=__builtin_amdgcn_mfma_f32_32x32x16_bf16(PAF(3),VFR(3),o[0],0,0,0), C1,8); \
    GAPB(o[1]=__builtin_amdgcn_mfma_f32_32x32x16_bf16(PAF(3),VFR(7),o[1],0,0,0), C1,12); \
    }while(0)
  int t=1;
  #undef CMASK
  #define CMASK(P0,P1,t) do{}while(0)
  for(;t+5<NT;t+=2){
    STEP(pB0,pB1,pA0,pA1,t,true,true,true);     WAIT_BAR(2); RESC(); ROT();
    STEP(pA0,pA1,pB0,pB1,t+1,true,true,true);   WAIT_BAR(2); RESC(); ROT();
  }
  #undef CMASK
  #define CMASK(P0,P1,t) do{int jb_=(t)-(NT-4); if(jb_>=0)cmask(P0,P1,jb_,qrel,hi);}while(0)
  #define ENDW(tt) do{ if((tt)+3<NT){WAIT_BAR(2);} else if((tt)+2<NT){WAIT_BAR(1);} else {WAIT_BAR(0);} }while(0)
  for(;t+1<NT;t+=2){
    STEP(pB0,pB1,pA0,pA1,t,(t+3<NT),(t+1<NT),(t+1<NT));       ENDW(t);   RESC(); ROT();
    STEP(pA0,pA1,pB0,pB1,t+1,(t+4<NT),(t+2<NT),(t+2<NT));     ENDW(t+1); RESC(); ROT();
  }
  STEP(pB0,pB1,pA0,pA1,NT-1,false,false,false); RESC();
  { float sacc=pB0[0]+pB0[1]; _Pragma("unroll") for(int r=2;r<16;++r)sacc+=pB0[r]; _Pragma("unroll") for(int r=0;r<16;++r)sacc+=pB1[r]; l_reg+=sacc;
    pw0=(u32x4){PKW(pB0,0),PKW(pB0,2),PKW(pB0,4),PKW(pB0,6)};pw1=(u32x4){PKW(pB0,8),PKW(pB0,10),PKW(pB0,12),PKW(pB0,14)};pw2=(u32x4){PKW(pB1,0),PKW(pB1,2),PKW(pB1,4),PKW(pB1,6)};pw3=(u32x4){PKW(pB1,8),PKW(pB1,10),PKW(pB1,12),PKW(pB1,14)};
    SBAR(); pv(o,vb0+sl_cur,PAF(0),PAF(1),PAF(2),PAF(3)); }
  #undef PKW
  #undef PAF
  #undef VFR
  #undef PIN
  #undef MX3
  #undef GAPA
  #undef GAPB
  #undef EX
  #undef VRD
  #undef KRD
  #undef STEP
  #undef ENDW
  {auto rr=__builtin_amdgcn_permlane32_swap(__float_as_uint(l_reg),__float_as_uint(l_reg),false,false);l_reg=__uint_as_float(rr[0])+__uint_as_float(rr[1]);}
  if(hi==0)wsf[32+r32]=l_reg;asm volatile("s_waitcnt lgkmcnt(0)":::"memory");
  float rli[16];
  #pragma unroll
  for(int r=0;r<16;++r)rli[r]=__builtin_amdgcn_rcpf(wsf[32+crow(r,hi)]);
  bf16*Ow=O+(rowbase+q0+wid*QBLK)*DM+h*D;
  { bf16*stg=(bf16*)(shm+LDS_OST)+wid*2048;
    #pragma unroll
    for(int r=0;r<16;++r){const int orow=crow(r,hi);
      #pragma unroll
      for(int d0=0;d0<2;++d0)stg[orow*64+d0*32+r32]=__float2bfloat16(o[d0][r]*rli[r]);}
    asm volatile("s_waitcnt lgkmcnt(0)":::"memory");
    #pragma unroll
    for(int i=0;i<4;++i){const int row=i*8+(lane>>3),ch=lane&7; const u32x4 v=*(const u32x4*)(stg+row*64+ch*8); ATTN_STORE16(Ow+(long)row*DM+ch*8,v);} }
  asm volatile("s_waitcnt lgkmcnt(0)\n\ts_barrier":::"memory");
  #undef DMA_K
  #undef DMA_V
  #undef CMASK
  #undef FBIAS
  #undef START
  #undef RESC
  #undef ROT
}
constexpr int ATTN_LDS_BYTES=LDS_BYTES;
struct AttnTensors { const bf16* Q; const bf16* K; const bf16* V; bf16* O; const float* F2; };
struct AttnUnit { int bh; int qb; };
struct StaticOrder {
  int vcu,G;
  __device__ __forceinline__ StaticOrder(int grid,int vcu_):vcu(vcu_),G(grid){}
  __device__ __forceinline__ bool next(int i,AttnUnit&u)const{ const int p=vcu+(i>>1)*G; if(p>=BATCH*NHEAD*NQB/2)return false; const int s=p%(NQB/2); u.bh=p/(NQB/2); u.qb=(i&1)?(NQB-1-s):s; return true; }
  __device__ __forceinline__ void a_ready(const AttnUnit&)const{}
  __device__ __forceinline__ void done(const AttnUnit&)const{}
};
template<class Sched,int THRL=8> __device__ __forceinline__ void attn_phase(char*lds,const AttnTensors&T,const Sched&S,const int wave_id){
  AttnUnit u;
  for(int i=0;S.next(i,u);++i){ S.a_ready(u); attn_unit<THRL>(u.bh/NHEAD,u.bh%NHEAD,u.qb,T.Q,T.K,T.V,T.O,T.F2+(size_t)u.bh*SEQ,lds,wave_id); S.done(u); }
}
#undef SBAR
#undef WAIT_BAR
}
#define GAS __attribute__((address_space(1)))
#define LAS __attribute__((address_space(3)))
typedef unsigned short bf16;
typedef unsigned v4u __attribute__((ext_vector_type(4)));
typedef float f32x4 __attribute__((ext_vector_type(4)));
typedef short bf16x8 __attribute__((ext_vector_type(8)));
typedef GAS unsigned gu32;
typedef GAS unsigned long long gu64;
#define RLX_AGENT __ATOMIC_RELAXED, __HIP_MEMORY_SCOPE_AGENT
#define LDS_WAIT() asm volatile("s_waitcnt lgkmcnt(0)" ::: "memory")
#define VM_WAIT() asm volatile("s_waitcnt vmcnt(0)" ::: "memory")
__device__ __forceinline__ unsigned long long rt() { return __builtin_amdgcn_s_memrealtime(); }
__device__ __forceinline__ unsigned f2bf(float f) { unsigned u = __builtin_bit_cast(unsigned, f); return (u + 0x7fffu + ((u >> 16) & 1u)) >> 16; }
__device__ __forceinline__ unsigned pk2(float lo, float hi) { return f2bf(lo) | (f2bf(hi) << 16); }

#define XB_TMO      128
#define XB_XCNT(j)  (256  + 64 * (j))
#define XB_XSUB(j)  (1280 + 64 * (j))
#define XB_XGEN(j)  (2304 + 64 * (j))
#define XB_TOP      3328
#define XB_TOPGEN   3392
#define XCD_BAR_WORDS 3456
#define XB_SPIN_CAP (1u << 18)

__device__ __forceinline__ unsigned xb_ld(unsigned* p)              { return __hip_atomic_load(p, __ATOMIC_RELAXED, __HIP_MEMORY_SCOPE_AGENT); }
__device__ __forceinline__ unsigned xb_add(unsigned* p, unsigned v) { return __hip_atomic_fetch_add(p, v, __ATOMIC_RELAXED, __HIP_MEMORY_SCOPE_AGENT); }
__device__ __forceinline__ unsigned xb_xcc_id() { return (unsigned)__builtin_amdgcn_s_getreg((3 << 11) | 20) & 0xFu; }
#define XB_SPIN(cond, bar) do { unsigned _sp = 0; while (cond) { __builtin_amdgcn_s_sleep(1); \
    if ((++_sp & 255u) == 0u) { if (xb_ld(&(bar)[XB_TMO])) break; if (_sp > XB_SPIN_CAP) { atomicAdd(&(bar)[XB_TMO], 1u); break; } } } } while (0)

struct XcdBarrier {
    unsigned* bar; unsigned x; unsigned wave;
    volatile LAS unsigned* st;
};

__device__ __forceinline__ XcdBarrier xcd_barrier_post(unsigned* bar, volatile LAS unsigned* st) {
    XcdBarrier b; b.bar = bar; b.x = xb_xcc_id(); b.st = st; b.wave = threadIdx.x >> 6;
    if (threadIdx.x == 0) (void)xb_add(&bar[XB_XCNT(b.x)], 1u);
    return b;
}
__device__ __forceinline__ void xcd_barrier_complete(unsigned* bar, unsigned x, unsigned& nloc, unsigned& nx, volatile LAS unsigned* st) {
    const unsigned G = st[2];
    unsigned sum, cnt, mine, sp = 0u;
    for (;;) {
        sum = 0u; cnt = 0u; mine = 0u;
#pragma unroll
        for (unsigned j = 0; j < 16; ++j) { const unsigned c = xb_ld(&bar[XB_XCNT(j)]); sum += c; cnt += (c > 0u) ? 1u : 0u; mine = (j == x) ? c : mine; }
        if (sum == G) break;
        __builtin_amdgcn_s_sleep(1);
        if ((++sp & 255u) == 0u) { if (xb_ld(&bar[XB_TMO])) break; if (sp > XB_SPIN_CAP) { atomicAdd(&bar[XB_TMO], 1u); break; } }
    }
    nloc = mine > 0u ? mine : 1u; nx = cnt > 0u ? cnt : 1u;
}

__device__ __forceinline__ void xcd_barrier(const XcdBarrier& b) {
    asm volatile("s_waitcnt vmcnt(0)" ::: "memory");
    __syncthreads();
    unsigned l0_; asm volatile("v_mbcnt_lo_u32_b32 %0, -1, 0\n\tv_mbcnt_hi_u32_b32 %0, -1, %0" : "=v"(l0_));
    if (b.wave == 0u && l0_ == 0u) {
        unsigned* bar = b.bar;
        __builtin_amdgcn_s_waitcnt(0);
        unsigned nloc = b.st[0], nx = b.st[1];
        if (nloc == 0u) { xcd_barrier_complete(bar, b.x, nloc, nx, b.st); b.st[0] = nloc; b.st[1] = nx; }
        const unsigned old = xb_add(&bar[XB_XSUB(b.x)], 1u);
        const unsigned gen = old / nloc;
        if (old + 1u == (gen + 1u) * nloc) {
            __builtin_amdgcn_fence(__ATOMIC_RELEASE, "agent");
            asm volatile("s_waitcnt vmcnt(0)" ::: "memory");
            const unsigned og = xb_add(&bar[XB_TOP], 1u);
            const unsigned tg = og / nx;
            if (og + 1u == (tg + 1u) * nx) xb_add(&bar[XB_TOPGEN], 1u);
            else XB_SPIN(xb_ld(&bar[XB_TOPGEN]) == tg, bar);
            __builtin_amdgcn_fence(__ATOMIC_ACQUIRE, "agent");
            xb_add(&bar[XB_XGEN(b.x)], 1u);
            asm volatile("s_waitcnt vmcnt(0)" ::: "memory");
        } else {
            XB_SPIN(xb_ld(&bar[XB_XGEN(b.x)]) == gen, bar);
            __builtin_amdgcn_fence(__ATOMIC_ACQUIRE, "agent");
            asm volatile("s_waitcnt vmcnt(0)" ::: "memory");
        }
    }
    __syncthreads();
}

constexpr int NWAVES = 8;
#ifndef MK_N_LAUNCHES
#define MK_N_LAUNCHES 1
#endif
constexpr int NPH = 34;
constexpr int N_LAUNCHES = MK_N_LAUNCHES;
static_assert(N_LAUNCHES == 1 || N_LAUNCHES == NPH, "MK_N_LAUNCHES is 1 or 34");

constexpr int NBATCH = 8, SEQ = 2048, T = NBATCH * SEQ, D = 1024, DFF = 3584, NE = 8, NH = 16;
constexpr int MAXBLK = 136;
constexpr float LN_EPS = 1e-5f;
constexpr float ALPHA = 1.6817928305074290f;
constexpr float LOG2E = 1.4426950408889634f;

constexpr size_t MiB = 1u << 20;
constexpr size_t WS_CTL = 0, CTL_ZERO_BYTES = 1 * MiB;
constexpr size_t WS_WIN = 2 * MiB;
constexpr size_t WS_WGATE = 10 * MiB;
constexpr size_t WS_WOUT = 11 * MiB;
constexpr size_t WS_WPOOL = 15 * MiB;
constexpr size_t WS_WQKV = 16 * MiB;
constexpr size_t WS_WO = 22 * MiB;
constexpr size_t WS_WGU = 24 * MiB;
constexpr size_t WS_WDN = 52 * MiB;
constexpr size_t WS_MGU = 66 * MiB;
constexpr size_t WS_MDN = 290 * MiB;
constexpr size_t WS_XF = 402 * MiB;
constexpr size_t WS_XB = 466 * MiB;
constexpr size_t WS_PRE = 498 * MiB;
constexpr size_t WS_S0 = 562 * MiB;
constexpr size_t WS_YG = WS_S0, WS_REC = WS_S0 + 32 * MiB, WS_XR = WS_S0 + 96 * MiB, WS_AA = WS_S0 + 128 * MiB, WS_BB = WS_S0 + 192 * MiB, WS_HY = WS_S0 + 256 * MiB;
constexpr size_t WS_PB = WS_S0;
constexpr size_t WS_Q = WS_S0, WS_K = WS_S0 + 32 * MiB, WS_V = WS_S0 + 64 * MiB;
constexpr size_t WS_HB = WS_S0;
constexpr size_t WS_ROWS = WS_S0, WS_HB2 = WS_S0 + 68 * MiB, WS_YROWS = WS_S0 + 306 * MiB;
constexpr size_t WS_TOK = WS_S0 + 442 * MiB, WS_GATE = WS_TOK + 1 * MiB, WS_DEST = WS_TOK + 2 * MiB, WS_BLKE = WS_TOK + 3 * MiB;
constexpr size_t WS_LOGF = WS_S0 + 446 * MiB, WS_F2 = WS_LOGF + 1 * MiB;
constexpr size_t WS_END = WS_S0 + 448 * MiB;
constexpr int CW_TMO = 0, CW_CODE = 1;
constexpr int CW_BAR = 4096;
constexpr int CW_CNT = 16384;

constexpr int RING_OFF = 0, RING_BYTES = 131072;
constexpr int LDSCTL_OFF = RING_BYTES, MISC_OFF = LDSCTL_OFF + 320;
constexpr int LDS_BYTES = 147456;
static_assert(MISC_OFF + 128 <= LDS_BYTES, "LDS map");

struct Frame {
    LAS unsigned char* lds;
    volatile LAS unsigned* MISC;
    int wave;
    int vcu, G;
};
struct Args { const float* in[22]; float* out; unsigned char* wsbase; int ph_lo, ph_hi; };
static_assert(sizeof(Args) == 24 * 8 + 8, "Args has no padding");
typedef __attribute__((address_space(4))) const Args* KArgs;
__device__ __forceinline__ KArgs kargs() { KArgs p = (KArgs)__builtin_amdgcn_kernarg_segment_ptr(); asm volatile("" : "+s"(p)); return p; }
#define INP(i) (kargs()->in[i])
#define WSP (kargs()->wsbase)
#define CTLP ((gu32*)(WSP + WS_CTL))
typedef float f32x2 __attribute__((ext_vector_type(2)));
typedef int i32x4 __attribute__((ext_vector_type(4)));
typedef int i32x2 __attribute__((ext_vector_type(2)));
typedef unsigned v2u __attribute__((ext_vector_type(2)));
__device__ __forceinline__ unsigned cvtpk(float lo, float hi) { unsigned r; asm volatile("v_cvt_pk_bf16_f32 %0, %1, %2" : "=v"(r) : "v"(lo), "v"(hi)); return r; }
__device__ __forceinline__ float bflo(unsigned w) { return __uint_as_float(w << 16); }
__device__ __forceinline__ float bfhi(unsigned w) { return __uint_as_float(w & 0xffff0000u); }
__device__ __forceinline__ float wave_sum(float v) {
#pragma unroll
    for (int o = 1; o < 64; o <<= 1) v += __shfl_xor(v, o);
    return v;
}

template <bool ILEAVE>
__device__ __forceinline__ void tr_tile(const float* __restrict__ W, int ldw, int K, bf16* WT, int ktile, int ntile, LAS unsigned* scr, int tid) {
    const int k0 = ktile * 128, n0 = ntile * 256, wave = tid >> 6, lane = tid & 63;
    const float* src = W + (size_t)(k0 + wave * 16) * ldw + n0 + lane;
#pragma unroll
    for (int i = 0; i < 8; ++i) {
        float lo[4], hi[4];
#pragma unroll
        for (int j = 0; j < 4; ++j) { lo[j] = src[(size_t)(2 * i) * ldw + 64 * j]; hi[j] = src[(size_t)(2 * i + 1) * ldw + 64 * j]; }
#pragma unroll
        for (int j = 0; j < 4; ++j) scr[(64 * j + lane) * 65 + wave * 8 + i] = cvtpk(lo[j], hi[j]);
    }
    __syncthreads();
#pragma unroll
    for (int it = 0; it < 8; ++it) {
        const int idx = it * 512 + tid, n = idx >> 4, q = idx & 15;
        const LAS unsigned* s = scr + n * 65 + 4 * q;
        v4u o; o.x = s[0]; o.y = s[1]; o.z = s[2]; o.w = s[3];
        int drow = n0 + n;
        if (ILEAVE) { const int part = drow >= DFF ? 1 : 0, j = drow - part * DFF; drow = 256 * (j >> 7) + 128 * part + (j & 127); }
        *(GAS v4u*)(WT + (size_t)drow * K + k0 + 8 * q) = o;
    }
    __syncthreads();
}
__device__ __forceinline__ void p0_prologue(Frame& F) {
    int wave_ = F.wave; asm volatile("" : "+s"(wave_)); const int wave = wave_, lane = pg8::fresh_lane(), tid = wave * 64 + lane; (void)tid;
    LAS unsigned* scr = (LAS unsigned*)(F.lds + RING_OFF);
    unsigned char* ws = WSP;
    constexpr int T_MGU = 8 * 28, T_MDN = 28 * 4, T_GU = 8 * 28, T_DN = 28 * 4, T_IN = 8 * 8, T_OUT = 8 * 4, T_QKV = 8 * 12, T_WO = 8 * 4, T_GATE = 1, T_POOL = 2;
    constexpr int N_MGU = 16 * T_MGU, N_MDN = 16 * T_MDN, N_GU = 2 * T_GU, N_DN = 2 * T_DN, N_IN = 2 * T_IN, N_OUT = 2 * T_OUT, N_GATE = 16 * T_GATE, N_POOL = 4 * T_POOL;
    constexpr int NT_ALL = N_MGU + N_MDN + N_GU + N_DN + N_IN + N_OUT + T_QKV + T_WO + N_GATE + N_POOL;
    for (int it = blockIdx.x; it < NT_ALL; it += F.G) {
        int r = it;
        if (r < N_MGU) { const int m = r / T_MGU, t = r % T_MGU; tr_tile<true>(INP(16) + (size_t)m * D * 2 * DFF, 2 * DFF, D, (bf16*)(ws + WS_MGU) + (size_t)m * 2 * DFF * D, t / 28, t % 28, scr, tid); continue; } r -= N_MGU;
        if (r < N_MDN) { const int m = r / T_MDN, t = r % T_MDN; tr_tile<false>(INP(17) + (size_t)m * DFF * D, D, DFF, (bf16*)(ws + WS_MDN) + (size_t)m * D * DFF, t / 4, t % 4, scr, tid); continue; } r -= N_MDN;
        if (r < N_GU) { const int m = r / T_GU, t = r % T_GU; tr_tile<true>(INP(13) + (size_t)m * D * 2 * DFF, 2 * DFF, D, (bf16*)(ws + WS_WGU) + (size_t)m * 2 * DFF * D, t / 28, t % 28, scr, tid); continue; } r -= N_GU;
        if (r < N_DN) { const int m = r / T_DN, t = r % T_DN; tr_tile<false>(INP(14) + (size_t)m * DFF * D, D, DFF, (bf16*)(ws + WS_WDN) + (size_t)m * D * DFF, t / 4, t % 4, scr, tid); continue; } r -= N_DN;
        if (r < N_IN) { const int m = r / T_IN, t = r % T_IN; tr_tile<false>(INP(1) + (size_t)m * D * 2 * D, 2 * D, D, (bf16*)(ws + WS_WIN) + (size_t)m * 2 * D * D, t / 8, t % 8, scr, tid); continue; } r -= N_IN;
        if (r < N_OUT) { const int m = r / T_OUT, t = r % T_OUT; tr_tile<false>(INP(7) + (size_t)m * D * D, D, D, (bf16*)(ws + WS_WOUT) + (size_t)m * D * D, t / 4, t % 4, scr, tid); continue; } r -= N_OUT;
        if (r < T_QKV) { tr_tile<false>(INP(10), 3 * D + NH, D, (bf16*)(ws + WS_WQKV), r / 12, r % 12, scr, tid); continue; } r -= T_QKV;
        if (r < T_WO) { tr_tile<false>(INP(12), D, D, (bf16*)(ws + WS_WO), r / 4, r % 4, scr, tid); continue; } r -= T_WO;
        if (r < N_GATE) { tr_tile<false>(INP(4) + (size_t)r * 128 * 256, 256, 128, (bf16*)(ws + WS_WGATE) + (size_t)r * 256 * 128, 0, 0, scr, tid); continue; } r -= N_GATE;
        { const int m = r / T_POOL, t = r % T_POOL; tr_tile<false>(INP(8) + (size_t)m * 256 * 256, 256, 256, (bf16*)(ws + WS_WPOOL) + (size_t)m * 256 * 256, t, 0, scr, tid); }
    }
    const GAS f32x4* x4 = (const GAS f32x4*)INP(0); GAS v2u* xb = (GAS v2u*)(ws + WS_XB);
    for (size_t i = (size_t)blockIdx.x * 512 + tid; i < (size_t)T * D / 4; i += (size_t)F.G * 512) { const f32x4 v = x4[i]; v2u o; o.x = cvtpk(v.x, v.y); o.y = cvtpk(v.z, v.w); xb[i] = o; }
}

__device__ __forceinline__ void ln_row(f32x4 (&v)[4], const float* g, const float* b, int lane) {
    float s = 0.f;
#pragma unroll
    for (int j = 0; j < 4; ++j) s += (v[j].x + v[j].y) + (v[j].z + v[j].w);
    const float mean = wave_sum(s) * (1.f / D); float s2 = 0.f;
#pragma unroll
    for (int j = 0; j < 4; ++j) { v[j] = v[j] - mean; s2 += (v[j].x * v[j].x + v[j].y * v[j].y) + (v[j].z * v[j].z + v[j].w * v[j].w); }
    const float rstd = 1.f / sqrtf(wave_sum(s2) * (1.f / D) + LN_EPS);
#pragma unroll
    for (int j = 0; j < 4; ++j) { const f32x4 gg = ((const f32x4*)g)[lane + 64 * j], bb = ((const f32x4*)b)[lane + 64 * j]; v[j] = v[j] * rstd * gg + bb; }
}
__device__ __forceinline__ void store_row(const f32x4 (&v)[4], float* xf_row, bf16* xb_row, int lane) {
#pragma unroll
    for (int j = 0; j < 4; ++j) ((GAS f32x4*)xf_row)[lane + 64 * j] = v[j];
    if (xb_row) {
#pragma unroll
        for (int j = 0; j < 4; ++j) { v2u o; o.x = cvtpk(v[j].x, v[j].y); o.y = cvtpk(v[j].z, v[j].w); ((GAS v2u*)xb_row)[lane + 64 * j] = o; }
    }
}
__device__ __forceinline__ void ln_phase(Frame& F, const float* pre, const float* g, const float* b, float* xf, bf16* xb) {
    int wave_ = F.wave; asm volatile("" : "+s"(wave_)); const int wave = wave_, lane = pg8::fresh_lane(), tid = wave * 64 + lane; (void)tid;
    const int gw = F.vcu * NWAVES + wave, NGW = F.G * NWAVES;
    for (int row = gw; row < T; row += NGW) {
        f32x4 v[4];
#pragma unroll
        for (int j = 0; j < 4; ++j) v[j] = ((const GAS f32x4*)(pre + (size_t)row * D))[lane + 64 * j];
        ln_row(v, g, b, lane);
        store_row(v, xf + (size_t)row * D, xb + (size_t)row * D, lane);
    }
}
__device__ __forceinline__ void ln_router_phase(Frame& F, const float* pre, const float* g, const float* b, float* xf, bf16* xb, const float* wr, gu32* cnt, i32x4* tok, f32x2* gate) {
    int wave_ = F.wave; asm volatile("" : "+s"(wave_)); const int wave = wave_, lane = pg8::fresh_lane(), tid = wave * 64 + lane; (void)tid;
    LAS unsigned* lcnt = (LAS unsigned*)(F.lds + RING_OFF);
    LAS unsigned* lbase = lcnt + 8;
    LAS int* rinfo = (LAS int*)(F.lds + RING_OFF + 256);
    LAS float* rgate = (LAS float*)(F.lds + RING_OFF + 256 + 1024);
    float w[4][4][8];
#pragma unroll
    for (int j = 0; j < 4; ++j)
#pragma unroll
        for (int i = 0; i < 4; ++i) { const f32x4* p = (const f32x4*)(wr + (size_t)(4 * (lane + 64 * j) + i) * NE); const f32x4 a = p[0], c = p[1];
            w[j][i][0] = a.x; w[j][i][1] = a.y; w[j][i][2] = a.z; w[j][i][3] = a.w; w[j][i][4] = c.x; w[j][i][5] = c.y; w[j][i][6] = c.z; w[j][i][7] = c.w; }
    for (int r0 = blockIdx.x * 64; r0 < T; r0 += F.G * 64) {
        if (tid < 8) lcnt[tid] = 0u;
        __syncthreads();
        for (int i8 = 0; i8 < 8; ++i8) {
            const int lr = wave * 8 + i8, row = r0 + lr;
            f32x4 v[4];
#pragma unroll
            for (int j = 0; j < 4; ++j) v[j] = ((const GAS f32x4*)(pre + (size_t)row * D))[lane + 64 * j];
            ln_row(v, g, b, lane);
            store_row(v, xf + (size_t)row * D, xb + (size_t)row * D, lane);
            float lg[8];
#pragma unroll
            for (int e = 0; e < 8; ++e) { float s = 0.f;
#pragma unroll
                for (int j = 0; j < 4; ++j) s += (v[j].x * w[j][0][e] + v[j].y * w[j][1][e]) + (v[j].z * w[j][2][e] + v[j].w * w[j][3][e]);
                lg[e] = wave_sum(s); }
            int e1 = 0; float v1 = lg[0];
#pragma unroll
            for (int e = 1; e < 8; ++e) if (lg[e] > v1) { v1 = lg[e]; e1 = e; }
            int e2 = -1; float v2 = -INFINITY;
#pragma unroll
            for (int e = 0; e < 8; ++e) if (e != e1 && lg[e] > v2) { v2 = lg[e]; e2 = e; }
            if (lane == 0) {
                const float ex = expf(v2 - v1), g1 = 1.f / (1.f + ex), g2 = ex * g1;
                const unsigned s1 = __hip_atomic_fetch_add(lcnt + e1, 1u, __ATOMIC_RELAXED, __HIP_MEMORY_SCOPE_WORKGROUP);
                const unsigned s2 = __hip_atomic_fetch_add(lcnt + e2, 1u, __ATOMIC_RELAXED, __HIP_MEMORY_SCOPE_WORKGROUP);
                rinfo[lr * 4 + 0] = e1; rinfo[lr * 4 + 1] = (int)s1; rinfo[lr * 4 + 2] = e2; rinfo[lr * 4 + 3] = (int)s2; rgate[lr * 2] = g1; rgate[lr * 2 + 1] = g2;
            }
        }
        __syncthreads();
        if (tid < 8) lbase[tid] = __hip_atomic_fetch_add(cnt + 64 * tid, lcnt[tid], RLX_AGENT);
        __syncthreads();
        if (tid < 64) { const int a1 = rinfo[tid * 4], a2 = rinfo[tid * 4 + 2];
            i32x4 o; o.x = a1; o.y = (int)lbase[a1] + rinfo[tid * 4 + 1]; o.z = a2; o.w = (int)lbase[a2] + rinfo[tid * 4 + 3];
            tok[r0 + tid] = o; f32x2 gg; gg.x = rgate[tid * 2]; gg.y = rgate[tid * 2 + 1]; gate[r0 + tid] = gg; }
        __syncthreads();
    }
}
__device__ __forceinline__ void gather_phase(Frame& F, gu32* cnt, const i32x4* tok, const bf16* xb, bf16* rows, i32x2* dest, int* blke) {
    int wave_ = F.wave; asm volatile("" : "+s"(wave_)); const int wave = wave_, lane = pg8::fresh_lane(), tid = wave * 64 + lane; (void)tid;
    int ps[8], pend[8]; int run = 0;
#pragma unroll
    for (int e = 0; e < 8; ++e) { const int c = (int)__hip_atomic_load(cnt + 64 * e, RLX_AGENT); ps[e] = run; run += (c + 255) & ~255; pend[e] = run; }
    const int gw = F.vcu * NWAVES + wave, NGW = F.G * NWAVES;
    for (int row = gw; row < T; row += NGW) {
        const i32x4 tk = tok[row];
        int p1 = ps[0], p2 = ps[0];
#pragma unroll
        for (int e = 1; e < 8; ++e) { p1 = (tk.x == e) ? ps[e] : p1; p2 = (tk.z == e) ? ps[e] : p2; }
        const int d1 = p1 + tk.y, d2 = p2 + tk.w;
        const GAS v4u* s = (const GAS v4u*)(xb + (size_t)row * D);
        const v4u a = s[lane], c = s[lane + 64];
        GAS v4u* o1 = (GAS v4u*)(rows + (size_t)d1 * D); GAS v4u* o2 = (GAS v4u*)(rows + (size_t)d2 * D);
        o1[lane] = a; o1[lane + 64] = c; o2[lane] = a; o2[lane + 64] = c;
        if (lane == 0) { i32x2 dd; dd.x = d1; dd.y = d2; dest[row] = dd; }
    }
    if (blockIdx.x == 0 && tid < MAXBLK) { const int start = tid * 256; int e = 0;
#pragma unroll
        for (int q = 0; q < 8; ++q) e += (pend[q] <= start) ? 1 : 0;
        blke[tid] = e < 7 ? e : 7;
        if (tid == 0) blke[200] = pend[7] / 256; }
}
template <bool FGATE>
__device__ __forceinline__ void combine_ln_phase(Frame& F, const float* xf_in, const float* yrows, const i32x2* dest, const f32x2* gate, const float* g, const float* b, float* xf_out, bf16* xb_out,
                                                  const float* wqkvf, const float* bfg, float* logf) {
    int wave_ = F.wave; asm volatile("" : "+s"(wave_)); const int wave = wave_, lane = pg8::fresh_lane(), tid = wave * 64 + lane; (void)tid;
    LAS float* wfT = (LAS float*)(F.lds + RING_OFF);
    if (FGATE) {
        for (int idx = tid; idx < D * NH; idx += 512) { const int d = idx >> 4, h = idx & 15; wfT[h * D + d] = wqkvf[(size_t)d * (3 * D + NH) + 3 * D + h]; }
        __syncthreads();
    }
    const int gw = F.vcu * NWAVES + wave, NGW = F.G * NWAVES;
    for (int row = gw; row < T; row += NGW) {
        const i32x2 dd = dest[row]; const f32x2 gg = gate[row];
        f32x4 v[4];
#pragma unroll
        for (int j = 0; j < 4; ++j) { const f32x4 x = ((const GAS f32x4*)(xf_in + (size_t)row * D))[lane + 64 * j];
            const f32x4 y1 = ((const GAS f32x4*)(yrows + (size_t)dd.x * D))[lane + 64 * j], y2 = ((const GAS f32x4*)(yrows + (size_t)dd.y * D))[lane + 64 * j];
            v[j] = x * ALPHA + (y1 * gg.x + y2 * gg.y); }
        ln_row(v, g, b, lane);
        store_row(v, xf_out + (size_t)row * D, xb_out ? xb_out + (size_t)row * D : nullptr, lane);
        if (FGATE) {
            float zz = 0.f;
#pragma unroll
            for (int h = 0; h < NH; ++h) { float s = 0.f;
#pragma unroll
                for (int j = 0; j < 4; ++j) { const f32x4 wv = ((const LAS f32x4*)(wfT + h * D))[lane + 64 * j]; s += (v[j].x * wv.x + v[j].y * wv.y) + (v[j].z * wv.z + v[j].w * wv.w); }
                s = wave_sum(s); zz = (lane == h) ? s : zz; }
            if (lane < NH) { const float z = zz + bfg[lane]; logf[(size_t)row * NH + lane] = fminf(z, 0.f) - log1pf(expf(-fabsf(z))); }
        }
    }
    if (FGATE) __syncthreads();
}
__device__ __forceinline__ void poolp_phase(Frame& F, const float* xf, bf16* pb) {
    int wave_ = F.wave; asm volatile("" : "+s"(wave_)); const int wave = wave_, lane = pg8::fresh_lane(), tid = wave * 64 + lane; (void)tid;
    LAS f32x4* tile = (LAS f32x4*)(F.lds + RING_OFF);
    for (int task = blockIdx.x; task < T / 64; task += F.G) {
        const int t0 = task * 64, pos0 = t0 & (SEQ - 1);
#pragma unroll
        for (int j = 0; j < 4; ++j) {
            const int w = 2 << j, halo = (pos0 >= w - 1) ? (w - 1) : 0;
            const int nrows = 64 + halo;
            for (int idx = tid; idx < nrows * 64; idx += 512) { const int r = idx >> 6, c4 = idx & 63;
                tile[r * 64 + c4] = ((const GAS f32x4*)(xf + (size_t)(t0 - halo + r) * D + 256 * j))[c4]; }
            __syncthreads();
            { const int c4 = tid & 63, tg = tid >> 6;
                f32x4 sum = (f32x4){0.f, 0.f, 0.f, 0.f};
                const int first = 8 * tg + halo;
#pragma unroll
                for (int kk = 1; kk < w; ++kk) if (first - kk >= 0) sum = sum + tile[(first - kk) * 64 + c4];
#pragma unroll
                for (int i = 0; i < 8; ++i) { const int tr = first + i, pos = pos0 + 8 * tg + i;
                    const f32x4 x0 = tile[tr * 64 + c4]; sum = sum + x0;
                    const float cntf = (float)((pos + 1) < w ? (pos + 1) : w);
                    const f32x4 pv = sum / cntf - x0;
                    v2u o; o.x = cvtpk(pv.x, pv.y); o.y = cvtpk(pv.z, pv.w); ((GAS v2u*)(pb + (size_t)(t0 + 8 * tg + i) * D + 256 * j))[c4] = o;
                    if (tr - (w - 1) >= 0) sum = sum - tile[(tr - (w - 1)) * 64 + c4]; } }
            __syncthreads();
        }
    }
}
__device__ __forceinline__ void conv_phase(Frame& F, const float* rec, const float* cw, const float* cb, bf16* xr) {
    int wave_ = F.wave; asm volatile("" : "+s"(wave_)); const int wave = wave_, lane = pg8::fresh_lane(), tid = wave * 64 + lane; (void)tid;
    const int gw = F.vcu * NWAVES + wave, NGW = F.G * NWAVES;
    f32x4 wk[2][4][2], bk[2][2];
#pragma unroll
    for (int j = 0; j < 2; ++j) { const int c = 8 * lane + 512 * j;
#pragma unroll
        for (int k = 0; k < 4; ++k) { wk[j][k][0] = *(const f32x4*)(cw + k * D + c); wk[j][k][1] = *(const f32x4*)(cw + k * D + c + 4); }
        bk[j][0] = *(const f32x4*)(cb + c); bk[j][1] = *(const f32x4*)(cb + c + 4); }
    for (int row = gw; row < T; row += NGW) {
        const int pos = row & (SEQ - 1);
#pragma unroll
        for (int j = 0; j < 2; ++j) { const int c = 8 * lane + 512 * j;
            f32x4 a0 = bk[j][0], a1 = bk[j][1];
#pragma unroll
            for (int k = 0; k < 4; ++k) { const int d = 3 - k;
                if (pos >= d) { const GAS f32x4* p = (const GAS f32x4*)(rec + (size_t)(row - d) * D + c); a0 = a0 + wk[j][k][0] * p[0]; a1 = a1 + wk[j][k][1] * p[1]; } }
            v4u o; o.x = cvtpk(a0.x, a0.y); o.y = cvtpk(a0.z, a0.w); o.z = cvtpk(a1.x, a1.y); o.w = cvtpk(a1.z, a1.w);
            *(GAS v4u*)(xr + (size_t)row * D + c) = o; }
    }
}
__device__ __forceinline__ void scan_phase(Frame& F, const float* AA, const float* BB, const bf16* YG, bf16* HY) {
    int wave_ = F.wave; asm volatile("" : "+s"(wave_)); const int wave = wave_, lane = pg8::fresh_lane(), tid = wave * 64 + lane; (void)tid;
    LAS float* sa = (LAS float*)(F.lds + RING_OFF); LAS float* sb = sa + 512 * 32;
    LAS float* sA = (LAS float*)(F.lds + LDSCTL_OFF + 4096); LAS float* sH = sA + 512; LAS float* sC = sH + 512; LAS float* sRun = sC + 512;
    const int k = tid >> 5, ch = tid & 31;
    for (int task = blockIdx.x; task < 256; task += F.G) {
        const int bb = task >> 5, c0 = (task & 31) * 32;
        if (tid < 32) sRun[tid] = 0.f;
        for (int q = 0; q < 4; ++q) {
            const size_t rbase = ((size_t)(bb * SEQ + q * 512)) * D + c0;
#pragma unroll
            for (int it = 0; it < 8; ++it) { const int r = it * 64 + (tid >> 3), pc = (tid & 7) * 4;
                const f32x4 va = *(const GAS f32x4*)(AA + rbase + (size_t)r * D + pc), vb = *(const GAS f32x4*)(BB + rbase + (size_t)r * D + pc);
                *(LAS f32x4*)(sa + r * 32 + pc) = va; *(LAS f32x4*)(sb + r * 32 + pc) = vb; }
            __syncthreads();
            float A = 1.f, Hh = 0.f;
#pragma unroll 8
            for (int s = 0; s < 32; ++s) { const float a = sa[(k * 32 + s) * 32 + ch], bv = sb[(k * 32 + s) * 32 + ch]; Hh = a * Hh + bv; A *= a; }
            sA[tid] = A; sH[tid] = Hh;
            __syncthreads();
            if (tid < 32) { float carry = sRun[tid];
                for (int kk = 0; kk < 16; ++kk) { sC[kk * 32 + tid] = carry; carry = sA[kk * 32 + tid] * carry + sH[kk * 32 + tid]; }
                sRun[tid] = carry; }
            __syncthreads();
            float h = sC[tid];
#pragma unroll 8
            for (int s = 0; s < 32; ++s) { const float a = sa[(k * 32 + s) * 32 + ch], bv = sb[(k * 32 + s) * 32 + ch]; h = a * h + bv; sb[(k * 32 + s) * 32 + ch] = h; }
            __syncthreads();
#pragma unroll
            for (int it = 0; it < 8; ++it) { const int r = it * 64 + (tid >> 3), pc = (tid & 7) * 4;
                const f32x4 hv = *(const LAS f32x4*)(sb + r * 32 + pc); const v2u yg = *(const GAS v2u*)(YG + rbase + (size_t)r * D + pc);
                v2u o; o.x = cvtpk(bflo(yg.x) * hv.x, bfhi(yg.x) * hv.y); o.y = cvtpk(bflo(yg.y) * hv.z, bfhi(yg.y) * hv.w);
                *(GAS v2u*)(HY + rbase + (size_t)r * D + pc) = o; }
            __syncthreads();
        }
    }
}
__device__ __forceinline__ void fcum_phase(Frame& F, const float* logf, float* F2) {
    int wave_ = F.wave; asm volatile("" : "+s"(wave_)); const int wave = wave_, lane = pg8::fresh_lane(), tid = wave * 64 + lane; (void)tid;
    LAS float* sW = (LAS float*)(F.lds + RING_OFF);
    for (int bh = blockIdx.x; bh < NBATCH * NH; bh += F.G) {
        const int bb = bh >> 4, h = bh & 15, s0 = 4 * tid;
        float v[4];
#pragma unroll
        for (int i = 0; i < 4; ++i) v[i] = logf[((size_t)bb * SEQ + s0 + i) * NH + h];
        v[1] += v[0]; v[2] += v[1]; v[3] += v[2];
        float x = v[3];
#pragma unroll
        for (int o = 1; o < 64; o <<= 1) { const float t = __shfl_up(x, o); if (lane >= o) x += t; }
        if (lane == 63) sW[wave] = x;
        __syncthreads();
        float off = x - v[3];
        for (int w = 0; w < wave; ++w) off += sW[w];
        f32x4 o; o.x = (off + v[0]) * LOG2E; o.y = (off + v[1]) * LOG2E; o.z = (off + v[2]) * LOG2E; o.w = (off + v[3]) * LOG2E;
        *(GAS f32x4*)(F2 + (size_t)bh * SEQ + s0) = o;
        __syncthreads();
    }
}

__global__ void __launch_bounds__(NWAVES * 64, 2) mk_fwd(Args args) {
    extern __shared__ __attribute__((aligned(16))) unsigned char lds[];
    Frame F;
    F.lds = (LAS unsigned char*)lds;
    F.MISC = (volatile LAS unsigned*)(F.lds + MISC_OFF);
    F.wave = __builtin_amdgcn_readfirstlane(threadIdx.x >> 6);
    F.G = gridDim.x; { const int bx = blockIdx.x; F.vcu = (F.G % 8 == 0) ? (bx % 8) * (F.G / 8) + bx / 8 : bx; }
    for (int u = threadIdx.x; u < (LDS_BYTES - LDSCTL_OFF) / 4; u += NWAVES * 64) ((LAS unsigned*)(F.lds + LDSCTL_OFF))[u] = 0u;
    __syncthreads();
    if (threadIdx.x == 0) F.MISC[10] = (unsigned)F.G;
    __syncthreads();
    if (N_LAUNCHES == 1) (void)xcd_barrier_post((unsigned*)CTLP + CW_BAR, F.MISC + 8);
#define GRID_BAR(seam) do { if (N_LAUNCHES != 1) { if (threadIdx.x == 0) __hip_atomic_store(CTLP + CW_TMO, 0xBADBA0u | (unsigned)(seam), RLX_AGENT); } \
    else { XcdBarrier b_; b_.bar = (unsigned*)CTLP + CW_BAR; b_.x = xb_xcc_id(); b_.st = F.MISC + 8; b_.wave = (unsigned)F.wave; xcd_barrier(b_); } } while (0)
    const int lo = args.ph_lo, hi = args.ph_hi;
#define IN(k) (lo <= (k) && (k) < hi)
#if defined(PROBE_A)
#define PSTAMP(k) do { if (blockIdx.x == 0 && threadIdx.x == 0) { const unsigned long long t_ = __builtin_amdgcn_s_memrealtime(); F.MISC[32 + 2 * (k)] = (unsigned)t_; F.MISC[33 + 2 * (k)] = (unsigned)(t_ >> 32); } } while (0)
#else
#define PSTAMP(k) do { } while (0)
#endif
#define SEAM(k) do { if (IN((k) + 1)) { GRID_BAR(k); PSTAMP((k) + 1); } } while (0)
#define ws WSP
#define XF ((float*)(WSP + WS_XF))
#define XB ((bf16*)(WSP + WS_XB))
#define PRE ((float*)(WSP + WS_PRE))
    const int G = F.G, cb = (int)blockIdx.x;

#define LRU_MIXER(P, J, RES) \
    if (IN(P)) { pg8::Gemm g{XB, (const bf16*)(ws + WS_WIN) + (size_t)(J) * 2 * D * D, D, D, D}; pg8::Order S; S.init(T / 256, 8, G, cb, 256u * D * 2, 0, 256u * D * 2, nullptr, 0); \
        pg8::EpiLruIn E{(bf16*)(ws + WS_YG), (float*)(ws + WS_REC)}; pg8::gemm_phase<pg8::EpiLruIn, pg8::Order, true, true>(F.lds + RING_OFF, g, S, E, F.wave); SEAM(P); } \
    if (IN((P) + 1)) { conv_phase(F, (const float*)(ws + WS_REC), INP(2) + (size_t)(J) * 4 * D, INP(3) + (size_t)(J) * D, (bf16*)(ws + WS_XR)); SEAM((P) + 1); } \
    if (IN((P) + 2)) { pg8::Gemm g{(const bf16*)(ws + WS_XR), (const bf16*)(ws + WS_WGATE) + (size_t)(J) * 8 * 256 * 128, D, 128, 128}; pg8::Order S; S.init(T / 256, 8, G, cb, 256u * D * 2, 128 * 2, 256u * 128 * 2, nullptr, 0); \
        pg8::EpiGates E{(const bf16*)(ws + WS_XR), INP(5) + (size_t)(J) * 8 * 256, INP(6) + (size_t)(J) * D, (float*)(ws + WS_AA), (float*)(ws + WS_BB)}; \
        pg8::gemm_phase<pg8::EpiGates, pg8::Order, true, true>(F.lds + RING_OFF, g, S, E, F.wave); SEAM((P) + 2); } \
    if (IN((P) + 3)) { scan_phase(F, (const float*)(ws + WS_AA), (const float*)(ws + WS_BB), (const bf16*)(ws + WS_YG), (bf16*)(ws + WS_HY)); SEAM((P) + 3); } \
    if (IN((P) + 4)) { pg8::Gemm g{(const bf16*)(ws + WS_HY), (const bf16*)(ws + WS_WOUT) + (size_t)(J) * D * D, D, D, D}; pg8::Order S; S.init(T / 256, 4, G, cb, 256u * D * 2, 0, 256u * D * 2, nullptr, 0); \
        pg8::EpiPre<true> E{RES, PRE, D, nullptr, ALPHA}; pg8::gemm_phase<pg8::EpiPre<true>, pg8::Order, true, true>(F.lds + RING_OFF, g, S, E, F.wave); SEAM((P) + 4); }
#define DENSE_FFN(P, I, L) \
    if (IN(P)) { pg8::Gemm g{XB, (const bf16*)(ws + WS_WGU) + (size_t)(I) * 2 * DFF * D, D, D, D}; pg8::Order S; S.init(T / 256, 2 * DFF / 256, G, cb, 256u * D * 2, 0, 256u * D * 2, nullptr, 0); \
        pg8::EpiSwiglu E{(bf16*)(ws + WS_HB), DFF}; pg8::gemm_phase<pg8::EpiSwiglu, pg8::Order, true, true>(F.lds + RING_OFF, g, S, E, F.wave); SEAM(P); } \
    if (IN((P) + 1)) { pg8::Gemm g{(const bf16*)(ws + WS_HB), (const bf16*)(ws + WS_WDN) + (size_t)(I) * D * DFF, DFF, DFF, DFF}; pg8::Order S; S.init(T / 256, 4, G, cb, 256u * DFF * 2, 0, 256u * DFF * 2, nullptr, 0); \
        pg8::EpiPre<true> E{XF, PRE, D, nullptr, ALPHA}; pg8::gemm_phase<pg8::EpiPre<true>, pg8::Order, true, true>(F.lds + RING_OFF, g, S, E, F.wave); SEAM((P) + 1); } \
    if (IN((P) + 2)) { ln_phase(F, PRE, INP(20) + (size_t)(L) * D, INP(21) + (size_t)(L) * D, XF, XB); SEAM((P) + 2); }
#define MOE_FFN(P, I, L, FG, XFO, XBO) \
    if (IN(P)) { ln_router_phase(F, PRE, INP(18) + (size_t)(L) * D, INP(19) + (size_t)(L) * D, XF, XB, INP(15) + (size_t)(I) * D * NE, CTLP + CW_CNT + (I) * 1024, (i32x4*)(ws + WS_TOK), (f32x2*)(ws + WS_GATE)); SEAM(P); } \
    if (IN((P) + 1)) { gather_phase(F, CTLP + CW_CNT + (I) * 1024, (const i32x4*)(ws + WS_TOK), XB, (bf16*)(ws + WS_ROWS), (i32x2*)(ws + WS_DEST), (int*)(ws + WS_BLKE) + (I) * 256); SEAM((P) + 1); } \
    if (IN((P) + 2)) { const int* blke = (const int*)(ws + WS_BLKE) + (I) * 256; const int nb = __builtin_amdgcn_readfirstlane(__hip_atomic_load(blke + 200, RLX_AGENT)); \
        pg8::Gemm g{(const bf16*)(ws + WS_ROWS), (const bf16*)(ws + WS_MGU) + (size_t)(I) * NE * 2 * DFF * D, D, D, D}; pg8::Order S; S.init(nb, 2 * DFF / 256, G, cb, 256u * D * 2, 0, 256u * D * 2, blke, 2u * DFF * D * 2); \
        pg8::EpiSwiglu E{(bf16*)(ws + WS_HB2), DFF}; pg8::gemm_phase<pg8::EpiSwiglu, pg8::Order, true, true>(F.lds + RING_OFF, g, S, E, F.wave); SEAM((P) + 2); } \
    if (IN((P) + 3)) { const int* blke = (const int*)(ws + WS_BLKE) + (I) * 256; const int nb = __builtin_amdgcn_readfirstlane(__hip_atomic_load(blke + 200, RLX_AGENT)); \
        pg8::Gemm g{(const bf16*)(ws + WS_HB2), (const bf16*)(ws + WS_MDN) + (size_t)(I) * NE * D * DFF, DFF, DFF, DFF}; pg8::Order S; S.init(nb, 4, G, cb, 256u * DFF * 2, 0, 256u * DFF * 2, blke, (unsigned)D * DFF * 2); \
        pg8::EpiPre<false> E{nullptr, (float*)(ws + WS_YROWS), D, nullptr, 1.f}; pg8::gemm_phase<pg8::EpiPre<false>, pg8::Order, true, true>(F.lds + RING_OFF, g, S, E, F.wave); SEAM((P) + 3); } \
    if (IN((P) + 4)) { combine_ln_phase<FG>(F, XF, (const float*)(ws + WS_YROWS), (const i32x2*)(ws + WS_DEST), (const f32x2*)(ws + WS_GATE), INP(20) + (size_t)(L) * D, INP(21) + (size_t)(L) * D, XFO, XBO, \
        INP(10), INP(11), (float*)(ws + WS_LOGF)); SEAM((P) + 4); }

    PSTAMP(0);
    if (IN(0)) { p0_prologue(F); SEAM(0); }
    LRU_MIXER(1, 0, INP(0))
    if (IN(6)) { ln_phase(F, PRE, INP(18), INP(19), XF, XB); SEAM(6); }
    DENSE_FFN(7, 0, 0)
    if (IN(10)) { poolp_phase(F, XF, (bf16*)(ws + WS_PB)); SEAM(10); }
    if (IN(11)) { pg8::Gemm g{(const bf16*)(ws + WS_PB), (const bf16*)(ws + WS_WPOOL), D, 256, 256}; pg8::Order S; S.init(T / 256, 4, G, cb, 256u * D * 2, 256 * 2, 256u * 256 * 2, nullptr, 0);
        pg8::EpiPre<true> E{XF, PRE, D, INP(9), ALPHA}; pg8::gemm_phase<pg8::EpiPre<true>, pg8::Order, true, true>(F.lds + RING_OFF, g, S, E, F.wave); SEAM(11); }
    MOE_FFN(12, 0, 1, true, XF, XB)
    if (IN(17)) { fcum_phase(F, (const float*)(ws + WS_LOGF), (float*)(ws + WS_F2));
        pg8::Gemm g{XB, (const bf16*)(ws + WS_WQKV), D, D, D}; pg8::Order S; S.init(T / 256, 12, G, cb, 256u * D * 2, 0, 256u * D * 2, nullptr, 0);
        pg8::EpiBf16 E{(bf16*)(ws + WS_Q), D, D, (size_t)(WS_K - WS_Q) / 2, attn_body::C2};
        pg8::gemm_phase<pg8::EpiBf16, pg8::Order, true, true>(F.lds + RING_OFF, g, S, E, F.wave); SEAM(17); }
    if (IN(18)) { const attn_body::AttnTensors AT{(const attn_body::bf16*)(ws + WS_Q), (const attn_body::bf16*)(ws + WS_K), (const attn_body::bf16*)(ws + WS_V), (attn_body::bf16*)(ws + WS_Q), (const float*)(ws + WS_F2)};
        const attn_body::StaticOrder S((int)F.G, F.vcu);
        attn_body::attn_phase<attn_body::StaticOrder>((char*)lds + RING_OFF, AT, S, F.wave); SEAM(18); }
    if (IN(19)) { pg8::Gemm g{(const bf16*)(ws + WS_Q), (const bf16*)(ws + WS_WO), D, D, D}; pg8::Order S; S.init(T / 256, 4, G, cb, 256u * D * 2, 0, 256u * D * 2, nullptr, 0);
        pg8::EpiPre<true> E{XF, PRE, D, nullptr, ALPHA}; pg8::gemm_phase<pg8::EpiPre<true>, pg8::Order, true, true>(F.lds + RING_OFF, g, S, E, F.wave); SEAM(19); }
    if (IN(20)) { ln_phase(F, PRE, INP(18) + 2 * D, INP(19) + 2 * D, XF, XB); SEAM(20); }
    DENSE_FFN(21, 1, 2)
    LRU_MIXER(24, 1, XF)
    MOE_FFN(29, 1, 3, false, kargs()->out, (bf16*)nullptr)
#if defined(PROBE_A)
    GRID_BAR(99); PSTAMP(NPH);
    if (blockIdx.x == 0) { __syncthreads();
        if (threadIdx.x == 0) {
#define PDUR(k) ((((unsigned long long)F.MISC[33 + 2 * ((k) + 1)] << 32) | F.MISC[32 + 2 * ((k) + 1)]) - (((unsigned long long)F.MISC[33 + 2 * (k)] << 32) | F.MISC[32 + 2 * (k)]))
            unsigned long long qa = (PDUR(PROBE_A) + 200) / 400, qb = (PDUR(PROBE_B) + PROBE_BU / 2) / PROBE_BU, qc = (PDUR(PROBE_C) + 300) / 600;
            if (qa > 127) qa = 127; if (qb > 127) qb = 127; if (qc > 89) qc = 89;
            const unsigned long long delay = qb * 51200ull + 0 * qa;
            const unsigned long long t0 = __builtin_amdgcn_s_memrealtime();
            while (__builtin_amdgcn_s_memrealtime() - t0 < delay) __builtin_amdgcn_s_sleep(32);
            asm volatile("s_waitcnt vmcnt(0)" ::: "memory");
            kargs()->out[0] += 1.0f + 0.1f * (float)qc;
        } }
#endif
#undef IN
#undef SEAM
#undef ws
#undef XF
#undef XB
#undef PRE
}

extern "C" void kernel_launch(void* const* d_in, const int* in_sizes, int n_in, void* d_out, int out_size, void* d_ws, size_t ws_size, hipStream_t stream) {
    static int grid = 0;
    if (grid == 0) {
        if (n_in != 22 || in_sizes[0] != T * D || out_size != T * D || ws_size < WS_END) { fprintf(stderr, "kernel_launch: unexpected shapes (n_in %d, in0 %d, out %d, ws %zu); nothing launched\n", n_in, n_in > 0 ? in_sizes[0] : -1, out_size, ws_size); grid = -1; return; }
        int dev = 0, cus = 0, per_cu = 0;
        if (hipGetDevice(&dev) != hipSuccess || hipDeviceGetAttribute(&cus, hipDeviceAttributeMultiprocessorCount, dev) != hipSuccess) { grid = -1; return; }
        if (hipFuncSetAttribute((const void*)mk_fwd, hipFuncAttributeMaxDynamicSharedMemorySize, LDS_BYTES) != hipSuccess) { fprintf(stderr, "kernel_launch: hipFuncSetAttribute failed\n"); grid = -1; return; }
        if (hipOccupancyMaxActiveBlocksPerMultiprocessor(&per_cu, (const void*)mk_fwd, NWAVES * 64, LDS_BYTES) != hipSuccess || per_cu < 1)
            fprintf(stderr, "kernel_launch: note: occupancy query reports %d workgroups per CU\n", per_cu);
        (void)hipGetLastError();
        grid = cus;
    }
    if (grid < 0) return;
    if (hipMemsetAsync((char*)d_ws + WS_CTL, 0, CTL_ZERO_BYTES, stream) != hipSuccess) { fprintf(stderr, "kernel_launch: hipMemsetAsync failed\n"); return; }
    Args a{};
    for (int i = 0; i < 22; ++i) a.in[i] = (const float*)d_in[i];
    a.out = (float*)d_out; a.wsbase = (unsigned char*)d_ws;
    for (int li = 0; li < N_LAUNCHES; ++li) {
        a.ph_lo = (N_LAUNCHES == 1) ? 0 : li; a.ph_hi = (N_LAUNCHES == 1) ? NPH : li + 1;
        hipLaunchKernelGGL(mk_fwd, dim3(grid), dim3(NWAVES * 64), LDS_BYTES, stream, a);
        const hipError_t le = hipPeekAtLastError();
        if (le != hipSuccess) { fprintf(stderr, "kernel_launch: launch %d failed: %s\n", li, hipGetErrorName(le)); break; }
    }
}
```
